# Optimizing an MI355X kernel written in HIP

```python
import jax, jax.numpy as jnp
from jax import lax
import numpy as np

D_MODEL = 1024
BATCH = 16
SEQ = 2048
DEPTH = 4

GLA_HEADS = 4
GLA_KEY = D_MODEL // 2
GLA_VAL = D_MODEL
GLA_DK = GLA_KEY // GLA_HEADS
GLA_DV = GLA_VAL // GLA_HEADS
GLA_GATE_RANK = 16
GLA_TAU = 16.0
GLA_CHUNK = 64
GLA_SPLITS = (GLA_KEY, GLA_KEY, GLA_VAL, GLA_VAL, GLA_GATE_RANK)
GLA_COLS = 2 * GLA_KEY + 2 * GLA_VAL + GLA_GATE_RANK
RWKV_DIM = D_MODEL // 2
RWKV_HEAD = 64
RWKV_HEADS = RWKV_DIM // RWKV_HEAD
RWKV_DECAY_RANK = 64
RWKV_A_RANK = 64
RWKV_G_RANK = 128
RWKV_SPLITS = (RWKV_DIM, RWKV_DECAY_RANK, RWKV_DIM, RWKV_DIM, RWKV_A_RANK, RWKV_G_RANK)
RWKV_COLS = 3 * RWKV_DIM + RWKV_DECAY_RANK + RWKV_A_RANK + RWKV_G_RANK
RWKV_LN_EPS = 64e-5
N_IN = GLA_COLS + RWKV_COLS + 2 * D_MODEL
FFN_DIM = ((8 * D_MODEL // 3 + 255) // 256) * 256
N_EXPERTS = 8
MOE_TOP_K = 2
MOE_FFN = 7 * D_MODEL // 2
N_DENSE = (DEPTH + 1) // 2
N_MOE = DEPTH // 2
NORM_EPS = 1e-6

kernel_name = 'hybrid_gla_rwkv7_moe_adaln'


def _rmsnorm(x, g):
    x32 = x.astype(jnp.float32)
    y = x32 * lax.rsqrt(jnp.mean(x32 * x32, axis=-1, keepdims=True) + NORM_EPS)
    return (y * g.astype(jnp.float32)).astype(x.dtype)


def _split(p, sizes):
    out = []
    o = 0
    for s in sizes:
        out.append(p[..., o:o + s])
        o += s
    return out


def _token_shift(p):
    return jnp.pad(p, ((0, 0), (1, 0), (0, 0)))[:, :-1, :]


def _gla_chunked(q, k, v, log_a):
    B_, S_, H, DKh = q.shape
    DVh = v.shape[-1]
    C = GLA_CHUNK
    N = S_ // C

    def to_chunks(t):
        return t.reshape(B_, N, C, H, t.shape[-1]).transpose(1, 0, 3, 2, 4)

    q, k, v, log_a = to_chunks(q), to_chunks(k), to_chunks(v), to_chunks(log_a)
    b = jnp.cumsum(log_a, axis=3)
    b_last = b[:, :, :, -1:, :]
    qe = q * jnp.exp(b)
    ke = k * jnp.exp(-b)
    kd = k * jnp.exp(b_last - b)
    causal = jnp.tril(jnp.ones((C, C), dtype=bool))
    att = jnp.where(causal, jnp.einsum('nbhid,nbhjd->nbhij', qe, ke), 0.0)
    o_intra = jnp.einsum('nbhij,nbhjv->nbhiv', att, v)

    def step(state, xs):
        qe_n, kd_n, v_n, dl_n = xs
        o_n = jnp.einsum('bhid,bhdv->bhiv', qe_n, state)
        state = dl_n[..., 0, :, None] * state + jnp.einsum('bhjd,bhjv->bhdv', kd_n, v_n)
        return state, o_n

    state0 = jnp.zeros((B_, H, DKh, DVh), q.dtype)
    _, o_inter = lax.scan(step, state0, (qe, kd, v, jnp.exp(b_last)))
    o = o_intra + o_inter
    return o.transpose(1, 0, 3, 2, 4).reshape(B_, S_, H, DVh)


def _gla_branch(pq, pk, pv, pg, pa, alpha_up, alpha_b, norm_g, w_o):
    B_, S_, _ = pq.shape
    f32 = jnp.float32
    q = pq.astype(f32).reshape(B_, S_, GLA_HEADS, GLA_DK) * (GLA_DK ** -0.5)
    k = pk.astype(f32).reshape(B_, S_, GLA_HEADS, GLA_DK)
    v = pv.astype(f32).reshape(B_, S_, GLA_HEADS, GLA_DV)
    log_a = jax.nn.log_sigmoid((pa.astype(f32) @ alpha_up + alpha_b).astype(f32)) / GLA_TAU
    log_a = log_a.reshape(B_, S_, GLA_HEADS, GLA_DK)
    o = _gla_chunked(q, k, v, log_a)
    o = o * lax.rsqrt(jnp.mean(o * o, axis=-1, keepdims=True) + 1e-5)
    o = o * norm_g.astype(f32).reshape(GLA_HEADS, GLA_DV)
    o = o.reshape(B_, S_, GLA_VAL) * jax.nn.silu(pg.astype(f32))
    return o.astype(pq.dtype) @ w_o


def _rwkv7_scan(r, w, k, v, a, b):
    B_, S_, H, N = r.shape
    xs = tuple(t.transpose(1, 0, 2, 3) for t in (r, w, k, v, a, b))

    def step(state, xt):
        r_t, w_t, k_t, v_t, a_t, b_t = xt
        sa = jnp.einsum('bhvk,bhk->bhv', state, a_t)
        state = (state * w_t[:, :, None, :] + sa[..., None] * b_t[:, :, None, :]
                 + v_t[..., None] * k_t[:, :, None, :])
        return state, jnp.einsum('bhvk,bhk->bhv', state, r_t)

    _, y = lax.scan(step, jnp.zeros((B_, H, N, N), r.dtype), xs)
    return y.transpose(1, 0, 2, 3)


def _rwkv7_branch(p, mu, w0, w2, a0, a2, g2, k_k, k_a, r_k, lnx_g, lnx_b, w_o):
    B_, S_, _ = p.shape
    f32 = jnp.float32
    p32 = p.astype(f32)
    p32 = p32 + (_token_shift(p32) - p32) * mu.astype(f32)
    r, wd, k, v, ad, gd = _split(p32, RWKV_SPLITS)
    w_log = -jax.nn.softplus(-(w0.astype(f32) + jnp.tanh(wd) @ w2.astype(f32))) - 0.5
    decay = jnp.exp(-jnp.exp(w_log))
    a = jax.nn.sigmoid(a0.astype(f32) + ad @ a2.astype(f32))
    g = jax.nn.sigmoid(gd) @ g2.astype(f32)

    def hr(t):
        return t.reshape(B_, S_, RWKV_HEADS, RWKV_HEAD)

    kk = hr(k * k_k.astype(f32))
    kk = kk / jnp.maximum(jnp.sqrt(jnp.sum(kk * kk, axis=-1, keepdims=True)), 1e-12)
    k = k * (1.0 + (a - 1.0) * k_a.astype(f32))
    rh, kh, vh = hr(r), hr(k), hr(v)
    y = _rwkv7_scan(rh, hr(decay), kh, vh, -kk, kk * hr(a))
    mean = jnp.mean(y, axis=-1, keepdims=True)
    var = jnp.mean(jnp.square(y - mean), axis=-1, keepdims=True)
    y = ((y - mean) * lax.rsqrt(var + RWKV_LN_EPS)).reshape(B_, S_, RWKV_DIM)
    y = y * lnx_g.astype(f32) + lnx_b.astype(f32)
    bonus = jnp.sum(rh * kh * r_k.astype(f32), axis=-1, keepdims=True) * vh
    y = (y + bonus.reshape(B_, S_, RWKV_DIM)) * g
    return y.astype(p.dtype) @ w_o


def _mixer(h, w_in, alpha_up, alpha_b, gla_norm_g, gla_w_o, mu, w0, w2, a0, a2, g2,
           k_k, k_a, r_k, lnx_g, lnx_b, rwkv_w_o, w_out):
    p = h @ w_in
    p_gla, p_rwkv, p_gate = _split(p, (GLA_COLS, RWKV_COLS, 2 * D_MODEL))
    pq, pk, pv, pg, pa = _split(p_gla, GLA_SPLITS)
    y_a = _gla_branch(pq, pk, pv, pg, pa, alpha_up, alpha_b, gla_norm_g, gla_w_o)
    y_b = _rwkv7_branch(p_rwkv, mu, w0, w2, a0, a2, g2, k_k, k_a, r_k, lnx_g, lnx_b, rwkv_w_o)
    gate_a, gate_b = _split(p_gate, (D_MODEL, D_MODEL))
    merged = jax.nn.sigmoid(gate_a) * y_a + jax.nn.sigmoid(gate_b) * y_b
    return merged.astype(h.dtype) @ w_out


def _swiglu(h, w1, w3, w2):
    return (jax.nn.silu(h @ w1) * (h @ w3)) @ w2


def _moe(h, router, w1, w3, w2):
    logits = (h @ router).astype(jnp.float32)
    top_v, top_i = lax.top_k(logits, MOE_TOP_K)
    wts = jax.nn.softmax(top_v, axis=-1)
    combine = jnp.sum(jax.nn.one_hot(top_i, N_EXPERTS, dtype=jnp.float32) * wts[..., None], axis=-2)
    combine = combine.astype(h.dtype)
    y = jnp.zeros_like(h)
    for e in range(N_EXPERTS):
        y = y + combine[..., e:e + 1] * _swiglu(h, w1[e], w3[e], w2[e])
    return y


def setup_inputs(seed: int = 0) -> dict:
    key = jax.random.key(seed)
    ks = jax.random.split(key, 32)
    f32 = jnp.float32
    L, D = DEPTH, D_MODEL

    def nrm(k, shape, s):
        return jax.random.normal(k, shape, f32) * s

    return {
        'x': nrm(ks[0], (BATCH, SEQ, D), 1.0),
        'c': nrm(ks[1], (BATCH, D), 1.0),
        'w_ada': nrm(ks[2], (L, D, 6 * D), 0.5 * D ** -0.5),
        'b_ada': nrm(ks[3], (L, 6 * D), 0.01),
        'ln1_g': 1.0 + nrm(ks[4], (L, D), 0.02),
        'ln2_g': 1.0 + nrm(ks[5], (L, D), 0.02),
        'w_in': nrm(ks[6], (L, D, N_IN), D ** -0.5),
        'gla_alpha_up': nrm(ks[7], (L, GLA_GATE_RANK, GLA_KEY), GLA_GATE_RANK ** -0.5),
        'gla_alpha_b': nrm(ks[8], (L, GLA_KEY), 0.1),
        'gla_norm_g': 1.0 + nrm(ks[9], (L, GLA_VAL), 0.02),
        'gla_w_o': nrm(ks[10], (L, GLA_VAL, D), GLA_VAL ** -0.5),
        'rwkv_mu': jax.random.uniform(ks[11], (L, RWKV_COLS), f32, 0.0, 1.0),
        'rwkv_w0': jax.random.uniform(ks[12], (L, RWKV_DIM), f32, -5.0, 0.0),
        'rwkv_w2': nrm(ks[13], (L, RWKV_DECAY_RANK, RWKV_DIM), 0.5 * RWKV_DECAY_RANK ** -0.5),
        'rwkv_a0': nrm(ks[14], (L, RWKV_DIM), 0.1),
        'rwkv_a2': nrm(ks[15], (L, RWKV_A_RANK, RWKV_DIM), RWKV_A_RANK ** -0.5),
        'rwkv_g2': nrm(ks[16], (L, RWKV_G_RANK, RWKV_DIM), RWKV_G_RANK ** -0.5),
        'rwkv_k_k': 0.85 + nrm(ks[17], (L, RWKV_DIM), 0.02),
        'rwkv_k_a': 1.0 + nrm(ks[18], (L, RWKV_DIM), 0.02),
        'rwkv_r_k': nrm(ks[19], (L, RWKV_HEADS, RWKV_HEAD), 0.1),
        'rwkv_lnx_g': 1.0 + nrm(ks[20], (L, RWKV_DIM), 0.02),
        'rwkv_lnx_b': nrm(ks[21], (L, RWKV_DIM), 0.01),
        'rwkv_w_o': nrm(ks[22], (L, RWKV_DIM, D), RWKV_DIM ** -0.5),
        'w_out': nrm(ks[23], (L, D, D), D ** -0.5),
        'ffn_w1': nrm(ks[24], (N_DENSE, D, FFN_DIM), D ** -0.5),
        'ffn_w3': nrm(ks[25], (N_DENSE, D, FFN_DIM), D ** -0.5),
        'ffn_w2': nrm(ks[26], (N_DENSE, FFN_DIM, D), FFN_DIM ** -0.5),
        'moe_router': nrm(ks[27], (N_MOE, D, N_EXPERTS), D ** -0.5),
        'moe_w1': nrm(ks[28], (N_MOE, N_EXPERTS, D, MOE_FFN), D ** -0.5),
        'moe_w3': nrm(ks[29], (N_MOE, N_EXPERTS, D, MOE_FFN), D ** -0.5),
        'moe_w2': nrm(ks[30], (N_MOE, N_EXPERTS, MOE_FFN, D), MOE_FFN ** -0.5),
        'lnf_g': 1.0 + nrm(ks[31], (D,), 0.02),
    }


def reference(x, c, w_ada, b_ada, ln1_g, ln2_g, w_in, gla_alpha_up, gla_alpha_b, gla_norm_g, gla_w_o,
              rwkv_mu, rwkv_w0, rwkv_w2, rwkv_a0, rwkv_a2, rwkv_g2, rwkv_k_k, rwkv_k_a, rwkv_r_k,
              rwkv_lnx_g, rwkv_lnx_b, rwkv_w_o, w_out, ffn_w1, ffn_w3, ffn_w2,
              moe_router, moe_w1, moe_w3, moe_w2, lnf_g):
    c_act = jax.nn.silu(c)
    for l in range(DEPTH):
        mod = c_act @ w_ada[l] + b_ada[l]
        sh1, sc1, g1, sh2, sc2, g2 = [m[:, None, :] for m in _split(mod, (D_MODEL,) * 6)]
        h = _rmsnorm(x, ln1_g[l]) * (1.0 + sc1) + sh1
        x = x + g1 * _mixer(h, w_in[l], gla_alpha_up[l], gla_alpha_b[l], gla_norm_g[l], gla_w_o[l],
                            rwkv_mu[l], rwkv_w0[l], rwkv_w2[l], rwkv_a0[l], rwkv_a2[l], rwkv_g2[l],
                            rwkv_k_k[l], rwkv_k_a[l], rwkv_r_k[l], rwkv_lnx_g[l], rwkv_lnx_b[l],
                            rwkv_w_o[l], w_out[l])
        h = _rmsnorm(x, ln2_g[l]) * (1.0 + sc2) + sh2
        if l % 2 == 0:
            f = _swiglu(h, ffn_w1[l // 2], ffn_w3[l // 2], ffn_w2[l // 2])
        else:
            f = _moe(h, moe_router[l // 2], moe_w1[l // 2], moe_w3[l // 2], moe_w2[l // 2])
        x = x + g2 * f
    return _rmsnorm(x, lnf_g)
```

```cpp
#include <hip/hip_runtime.h>
#include <cstdio>
#include <cstdint>
#ifndef MK_FUSED
#define MK_FUSED 0
#endif
namespace pg8 {
#define PG8_LAS __attribute__((address_space(3)))
typedef unsigned short bf16_t;
typedef short bf16x8 __attribute__((ext_vector_type(8)));
typedef float f32x4 __attribute__((ext_vector_type(4)));
typedef unsigned u32x4 __attribute__((ext_vector_type(4)));
constexpr int BM = 256, BK = 64, HALF = 128, HTB = HALF * BK * 2  , STAGE_BYTES = 8 * HTB, NXCD = 8, WGM = 8;

__host__ __device__ __forceinline__ int lds_byte(int r, int c) { const int st = (r >> 4) * 2 + (c >> 5), rr = r & 15, cc = c & 31, ob = rr * 64 + cc * 2; return st * 1024 + (ob ^ (((ob >> 9) & 1) << 5)); }
__host__ __device__ __forceinline__ void stage_rc(int b, int& R, int& C) { const int st = b / 1024, sb = b % 1024, swz = sb ^ (((sb >> 9) & 1) << 5); R = (st >> 1) * 16 + swz / 64; C = (st & 1) * 32 + (swz % 64) / 2; }
__host__ __device__ __forceinline__ int perm32(int rho) { const int n = rho >> 4, i = rho & 15; return 8 * (i >> 2) + 4 * n + (i & 3); }

struct Unit { int pm, pn; };
struct Gemm { const bf16_t* A; const bf16_t* Bt; int M, N, K; };

struct StaticOrder {
    int nM, nN, nwg, G, c;
    __host__ __device__ void init(int M, int N, int G_, int c_) { nM = M / BM; nN = N / BM; nwg = nM * nN; G = G_; c = c_; }
    __host__ __device__ bool next(int i, Unit& u) const {
        const long L = (long)i * G + c; if (L >= nwg) return false;
        int wgid = (int)L; { const int q = nwg / NXCD, r = nwg % NXCD, xcd = wgid % NXCD, off = wgid / NXCD; wgid = (xcd < r ? xcd * (q + 1) : r * (q + 1) + (xcd - r) * q) + off; }
        const int nig = WGM * nN, gid = wgid / nig, fm = gid * WGM, gsz = (nM - fm) < WGM ? (nM - fm) : WGM;
        u.pm = fm + ((wgid % nig) % gsz); u.pn = (wgid % nig) / gsz; return true;
    }
    __device__ __forceinline__ void a_ready(const Unit&) const {}
    __device__ __forceinline__ void done(const Unit&) const {}
};
__device__ __forceinline__ unsigned cvt_pk_bf16(float lo, float hi) { unsigned r; asm volatile("v_cvt_pk_bf16_f32 %0, %1, %2" : "=v"(r) : "v"(lo), "v"(hi)); return r; }
typedef float f32x2 __attribute__((ext_vector_type(2)));

__device__ __forceinline__ float bf_lo(unsigned w) { return __uint_as_float(w << 16); }
__device__ __forceinline__ float bf_hi(unsigned w) { return __uint_as_float(w & 0xffff0000u); }
__device__ __forceinline__ float fsigmoid(float x) { return __builtin_amdgcn_rcpf(1.0f + __builtin_amdgcn_exp2f(-1.4426950408889634f * x)); }
__device__ __forceinline__ float fsilu(float x) { return x * fsigmoid(x); }

struct EpiPlain {
    static constexpr bool PERM = true, AFTER_DRAIN = false;
    bf16_t* O; int ldc; int pn_mod;
    __device__ __forceinline__ void operator()(const f32x4 (&acc)[2][2][4][2], const Unit& u, int wr, int wc, int fr, int fq) const {
        const int row0 = u.pm * BM + wr * 64 + fr, col0 = (u.pn % pn_mod) * BM + wc * 32 + 8 * fq;
#pragma unroll
        for (int ai = 0; ai < 2; ++ai)
#pragma unroll
            for (int m = 0; m < 4; ++m) { bf16_t* rowp = O + (size_t)(row0 + ai * HALF + m * 16) * ldc + col0;
#pragma unroll
                for (int bj = 0; bj < 2; ++bj) { const f32x4 v0 = acc[ai][bj][m][0], v1 = acc[ai][bj][m][1];
                    u32x4 w; w.x = cvt_pk_bf16(v0[0], v0[1]); w.y = cvt_pk_bf16(v0[2], v0[3]); w.z = cvt_pk_bf16(v1[0], v1[1]); w.w = cvt_pk_bf16(v1[2], v1[3]);
                    *(u32x4*)(rowp + bj * HALF) = w; } }
    }
};
struct EpiGate {
    static constexpr bool PERM = true, AFTER_DRAIN = false;
    bf16_t* O; const bf16_t* T; const bf16_t* gate; int ldc, ldg, gcol0;
    __device__ __forceinline__ void operator()(const f32x4 (&acc)[2][2][4][2], const Unit& u, int wr, int wc, int fr, int fq) const {
        const int row0 = u.pm * BM + wr * 64 + fr, col0 = u.pn * BM + wc * 32 + 8 * fq;
#pragma unroll
        for (int ai = 0; ai < 2; ++ai)
#pragma unroll
            for (int m = 0; m < 4; ++m) { const size_t r = (size_t)(row0 + ai * HALF + m * 16);
#pragma unroll
                for (int bj = 0; bj < 2; ++bj) { const f32x4 v0 = acc[ai][bj][m][0], v1 = acc[ai][bj][m][1];
                    const u32x4 g = *(const u32x4*)(gate + r * ldg + gcol0 + col0 + bj * HALF);
                    float o[8];
                    o[0] = fsigmoid(bf_lo(g.x)) * v0[0]; o[1] = fsigmoid(bf_hi(g.x)) * v0[1]; o[2] = fsigmoid(bf_lo(g.y)) * v0[2]; o[3] = fsigmoid(bf_hi(g.y)) * v0[3];
                    o[4] = fsigmoid(bf_lo(g.z)) * v1[0]; o[5] = fsigmoid(bf_hi(g.z)) * v1[1]; o[6] = fsigmoid(bf_lo(g.w)) * v1[2]; o[7] = fsigmoid(bf_hi(g.w)) * v1[3];
                    if (T) { const u32x4 t = *(const u32x4*)(T + r * ldc + col0 + bj * HALF);
                        o[0] += bf_lo(t.x); o[1] += bf_hi(t.x); o[2] += bf_lo(t.y); o[3] += bf_hi(t.y); o[4] += bf_lo(t.z); o[5] += bf_hi(t.z); o[6] += bf_lo(t.w); o[7] += bf_hi(t.w); }
                    u32x4 w; w.x = cvt_pk_bf16(o[0], o[1]); w.y = cvt_pk_bf16(o[2], o[3]); w.z = cvt_pk_bf16(o[4], o[5]); w.w = cvt_pk_bf16(o[6], o[7]);
                    *(u32x4*)(O + r * ldc + col0 + bj * HALF) = w; } }
    }
};
struct EpiResid {
    static constexpr bool PERM = false, AFTER_DRAIN = false;
    const float* Xin; float* Xout; const float* gbias; const float* gpart; size_t part_stride;
    __device__ __forceinline__ void operator()(const f32x4 (&acc)[2][2][4][2], const Unit& u, int wr, int wc, int fr, int fq) const {
        const int row0 = u.pm * BM + wr * 64 + fr, col0 = u.pn * BM + wc * 32 + 4 * fq; const int b = u.pm >> 3;
        f32x4 gv[2][2];
#pragma unroll
        for (int bj = 0; bj < 2; ++bj)
#pragma unroll
            for (int n = 0; n < 2; ++n) { const int c = col0 + bj * HALF + n * 16; f32x4 g = *(const f32x4*)(gbias + c);
#pragma unroll
                for (int q = 0; q < 4; ++q) g += *(const f32x4*)(gpart + q * part_stride + (size_t)b * 6144 + c);
                gv[bj][n] = g; }
#pragma unroll
        for (int ai = 0; ai < 2; ++ai)
#pragma unroll
            for (int m = 0; m < 4; ++m) { const size_t off = (size_t)(row0 + ai * HALF + m * 16) * 1024 + col0;
#pragma unroll
                for (int bj = 0; bj < 2; ++bj)
#pragma unroll
                    for (int n = 0; n < 2; ++n) { const f32x4 xi = *(const f32x4*)(Xin + off + bj * HALF + n * 16);
                        *(f32x4*)(Xout + off + bj * HALF + n * 16) = xi + gv[bj][n] * acc[ai][bj][m][n]; } }
    }
};
struct EpiSwiglu {
    static constexpr bool PERM = true, AFTER_DRAIN = false;
    bf16_t* U; int ldc; int pn_mod;
    __device__ __forceinline__ void operator()(const f32x4 (&acc)[2][2][4][2], const Unit& u, int wr, int wc, int fr, int fq) const {
        const int row0 = u.pm * BM + wr * 64 + fr, col0 = (u.pn % pn_mod) * HALF + wc * 32 + 8 * fq;
#pragma unroll
        for (int ai = 0; ai < 2; ++ai)
#pragma unroll
            for (int m = 0; m < 4; ++m) { bf16_t* rowp = U + (size_t)(row0 + ai * HALF + m * 16) * ldc + col0;
                const f32x4 g0 = acc[ai][0][m][0], g1 = acc[ai][0][m][1], u0 = acc[ai][1][m][0], u1 = acc[ai][1][m][1];
                u32x4 w; w.x = cvt_pk_bf16(fsilu(g0[0]) * u0[0], fsilu(g0[1]) * u0[1]); w.y = cvt_pk_bf16(fsilu(g0[2]) * u0[2], fsilu(g0[3]) * u0[3]);
                w.z = cvt_pk_bf16(fsilu(g1[0]) * u1[0], fsilu(g1[1]) * u1[1]); w.w = cvt_pk_bf16(fsilu(g1[2]) * u1[2], fsilu(g1[3]) * u1[3]);
                *(u32x4*)rowp = w; }
    }
};
struct MoeOrder : StaticOrder {
    const int* tile_e; int nNloc;
    __device__ void init_moe(int nT, int nN_, int G_, int c_, const int* te) { nM = nT; nN = nN_; nwg = nM * nN; G = G_; c = c_; tile_e = te; nNloc = nN_; }
    __device__ bool next(int i, Unit& u) const {
        if (!StaticOrder::next(i, u)) return false;
        const int e = __builtin_amdgcn_readfirstlane(tile_e[u.pm]); u.pn += e * nNloc; return true;
    }
};
template <class Epi, class Sched, bool ALIGN_EPI = false, bool SP2 = false>
__device__ __forceinline__ void gemm_phase(PG8_LAS unsigned char* lds, const Gemm g, const Sched& S, const Epi& E) {
    int tid_ = threadIdx.x; asm volatile("" : "+v"(tid_));
    const int tid = tid_, wid = __builtin_amdgcn_readfirstlane(tid >> 6), lane = tid & 63, wr = wid >> 2, wc = wid & 3, fr = lane & 15, fq = lane >> 4;
    const int K = g.K, nt = K / BK;
    unsigned voffA[2], voffB[2];
#pragma unroll
    for (int i = 0; i < 2; ++i) { int R, C; stage_rc(tid * 16 + i * 8192, R, C); const int Rb = Epi::PERM ? ((R & ~31) + perm32(R & 31)) : R;
        voffA[i] = (unsigned)(R * K + C) * 2u; voffB[i] = (unsigned)(Rb * K + C) * 2u; }
    const size_t kstep = (size_t)(BK * 2);
    const size_t hstep = (size_t)HALF * K * 2;
    const size_t tstep = 2 * hstep;
    const unsigned ldsw = (unsigned)wid * 1024u;
    const int aoff = lds_byte(wr * 64 + fr, fq * 8), boff = lds_byte(wc * 32 + fr, fq * 8);
#define PG8_SA(b, h) (((b) * 2 + (h)) * HTB)
#define PG8_SB(b, h) ((4 + (b) * 2 + (h)) * HTB)
#define PG8_STAGE(bufoff, gbase, voff) do { _Pragma("unroll") for (int _i = 0; _i < 2; ++_i) \
        __builtin_amdgcn_global_load_lds((const unsigned*)((const char*)(gbase) + (voff)[_i]), (PG8_LAS unsigned*)(lds + (bufoff) + ldsw + _i * 8192), 16, 0, 0); } while (0)
#define PG8_LDA(dst, b, h) do { _Pragma("unroll") for (int m = 0; m < 4; ++m) _Pragma("unroll") for (int k = 0; k < 2; ++k) dst[m][k] = *(const PG8_LAS bf16x8*)(lds + PG8_SA(b, h) + aoff + m * 2048 + k * 1024); } while (0)
#define PG8_LDB(dst, b, h) do { _Pragma("unroll") for (int n = 0; n < 2; ++n) _Pragma("unroll") for (int k = 0; k < 2; ++k) dst[n][k] = *(const PG8_LAS bf16x8*)(lds + PG8_SB(b, h) + boff + n * 2048 + k * 1024); } while (0)
#define PG8_MMA(ai, bj, At, Bt) do { __builtin_amdgcn_s_setprio(1); _Pragma("unroll") for (int m = 0; m < 4; ++m) _Pragma("unroll") for (int n = 0; n < 2; ++n) _Pragma("unroll") for (int k = 0; k < 2; ++k) \
        acc[ai][bj][m][n] = __builtin_amdgcn_mfma_f32_16x16x32_bf16(Bt[n][k], At[m][k], acc[ai][bj][m][n], 0, 0, 0); __builtin_amdgcn_s_setprio(0); } while (0)
#define PG8_WAIT_V(n) asm volatile("s_waitcnt vmcnt(" #n ")" ::: "memory")
#define PG8_WAIT_L(n) asm volatile("s_waitcnt lgkmcnt(" #n ")" ::: "memory")
#define PG8_BAR __builtin_amdgcn_s_barrier()
#define PG8_SCHED __builtin_amdgcn_sched_barrier(0)
    Unit cur, nxt; int ui = 0;
    if (!S.next(0, cur)) return;
    f32x4 acc[2][2][4][2];
#pragma unroll
    for (int a = 0; a < 2; ++a)
#pragma unroll
        for (int b = 0; b < 2; ++b)
#pragma unroll
            for (int m = 0; m < 4; ++m)
#pragma unroll
                for (int n = 0; n < 2; ++n) acc[a][b][m][n] = (f32x4){0.f, 0.f, 0.f, 0.f};
    bf16x8 At[4][2], B0[2][2], B1[2][2];
    const char* cA = (const char*)g.A + (size_t)cur.pm * tstep; const char* cB = (const char*)g.Bt + (size_t)cur.pn * tstep;
    S.a_ready(cur);
    if constexpr (SP2) {
        PG8_STAGE(PG8_SB(0, 0), cB, voffB); PG8_STAGE(PG8_SB(0, 1), cB + hstep, voffB); PG8_STAGE(PG8_SA(0, 0), cA, voffA); PG8_STAGE(PG8_SA(0, 1), cA + hstep, voffA);
        if (wr == 1) PG8_BAR;
        PG8_WAIT_V(2); PG8_BAR;
        PG8_STAGE(PG8_SB(1, 0), cB + kstep, voffB); PG8_STAGE(PG8_SA(1, 0), cA + kstep, voffA); PG8_STAGE(PG8_SB(1, 1), cB + hstep + kstep, voffB);
        PG8_WAIT_V(6); PG8_BAR;
    } else {
        PG8_STAGE(PG8_SB(0, 0), cB, voffB); PG8_STAGE(PG8_SA(0, 0), cA, voffA); PG8_STAGE(PG8_SB(0, 1), cB + hstep, voffB); PG8_STAGE(PG8_SA(0, 1), cA + hstep, voffA);
        if (wr == 1) PG8_BAR;
        PG8_WAIT_V(4); PG8_BAR;
        PG8_STAGE(PG8_SB(1, 0), cB + kstep, voffB); PG8_STAGE(PG8_SA(1, 0), cA + kstep, voffA); PG8_STAGE(PG8_SB(1, 1), cB + hstep + kstep, voffB);
        PG8_WAIT_V(6); PG8_BAR;
    }
    for (;;) {
        const bool has_next = S.next(ui + 1, nxt);
        const char* nA = has_next ? (const char*)g.A + (size_t)nxt.pm * tstep : cA; const char* nB = has_next ? (const char*)g.Bt + (size_t)nxt.pn * tstep : cB;
        for (int t = 0; t < nt; t += 2) {
            const bool last = (t == nt - 2);
            const char* a1 = cA + (size_t)(t + 1) * kstep;
            const char* a2 = last ? nA : cA + (size_t)(t + 2) * kstep; const char* b2 = last ? nB : cB + (size_t)(t + 2) * kstep;
            const char* a3 = a2 + kstep; const char* b3 = b2 + kstep;
            if (last && has_next) S.a_ready(nxt);
            if constexpr (SP2) {
            PG8_LDB(B0, 0, 0); PG8_LDB(B1, 0, 1); PG8_SCHED; PG8_LDA(At, 0, 0); PG8_STAGE(PG8_SA(1, 1), a1 + hstep, voffA);
            PG8_WAIT_V(8); PG8_WAIT_L(0); PG8_BAR; PG8_MMA(0, 0, At, B0); PG8_MMA(0, 1, At, B1); PG8_BAR; PG8_SCHED;
            PG8_LDA(At, 0, 1); PG8_STAGE(PG8_SB(0, 0), b2, voffB); PG8_STAGE(PG8_SB(0, 1), b2 + hstep, voffB); PG8_STAGE(PG8_SA(0, 0), a2, voffA);
            PG8_WAIT_V(8); PG8_WAIT_L(0); PG8_BAR; PG8_MMA(1, 0, At, B0); PG8_MMA(1, 1, At, B1); PG8_BAR; PG8_SCHED;
            PG8_LDB(B0, 1, 0); PG8_LDB(B1, 1, 1); PG8_SCHED; PG8_LDA(At, 1, 0); PG8_STAGE(PG8_SA(0, 1), a2 + hstep, voffA);
            PG8_WAIT_V(8); PG8_WAIT_L(0); PG8_BAR; PG8_MMA(0, 0, At, B0); PG8_MMA(0, 1, At, B1); PG8_BAR; PG8_SCHED;
            PG8_LDA(At, 1, 1); PG8_STAGE(PG8_SB(1, 0), b3, voffB); PG8_STAGE(PG8_SB(1, 1), b3 + hstep, voffB); PG8_STAGE(PG8_SA(1, 0), a3, voffA);
            PG8_WAIT_V(8); PG8_WAIT_L(0); PG8_BAR; PG8_MMA(1, 0, At, B0); PG8_MMA(1, 1, At, B1); PG8_BAR; PG8_SCHED;
            } else {
            PG8_LDB(B0, 0, 0); PG8_SCHED; PG8_LDA(At, 0, 0); PG8_STAGE(PG8_SA(1, 1), a1 + hstep, voffA);
            PG8_WAIT_L(8); PG8_BAR; PG8_WAIT_L(0); PG8_MMA(0, 0, At, B0); PG8_BAR; PG8_SCHED;
            PG8_LDB(B1, 0, 1); PG8_STAGE(PG8_SB(0, 0), b2, voffB);
            PG8_BAR; PG8_WAIT_L(0); PG8_MMA(0, 1, At, B1); PG8_BAR;
            PG8_LDA(At, 0, 1); PG8_STAGE(PG8_SA(0, 0), a2, voffA);
            PG8_BAR; PG8_WAIT_L(0); PG8_MMA(1, 0, At, B0); PG8_BAR; PG8_SCHED;
            PG8_STAGE(PG8_SB(0, 1), b2 + hstep, voffB);
            PG8_WAIT_V(6); PG8_BAR; PG8_MMA(1, 1, At, B1); PG8_BAR;
            PG8_LDB(B0, 1, 0); PG8_SCHED; PG8_LDA(At, 1, 0); PG8_STAGE(PG8_SA(0, 1), a2 + hstep, voffA);
            PG8_WAIT_L(8); PG8_BAR; PG8_WAIT_L(0); PG8_MMA(0, 0, At, B0); PG8_BAR; PG8_SCHED;
            PG8_LDB(B1, 1, 1); PG8_STAGE(PG8_SB(1, 0), b3, voffB);
            PG8_BAR; PG8_WAIT_L(0); PG8_MMA(0, 1, At, B1); PG8_BAR;
            PG8_LDA(At, 1, 1); PG8_STAGE(PG8_SA(1, 0), a3, voffA);
            PG8_BAR; PG8_WAIT_L(0); PG8_MMA(1, 0, At, B0); PG8_BAR; PG8_SCHED;
            PG8_STAGE(PG8_SB(1, 1), b3 + hstep, voffB);
            PG8_WAIT_V(6); PG8_BAR; PG8_MMA(1, 1, At, B1); PG8_BAR;
            }
        }
        if constexpr (ALIGN_EPI) { if (wr == 0) PG8_BAR; }
        if constexpr (!Epi::AFTER_DRAIN) { E(acc, cur, wr, wc, fr, fq); S.done(cur); }
        if (!has_next) break;
#pragma unroll
        for (int a = 0; a < 2; ++a)
#pragma unroll
            for (int b = 0; b < 2; ++b)
#pragma unroll
                for (int m = 0; m < 4; ++m)
#pragma unroll
                    for (int n = 0; n < 2; ++n) acc[a][b][m][n] = (f32x4){0.f, 0.f, 0.f, 0.f};
        cur = nxt; cA = nA; cB = nB; ++ui;
        if constexpr (ALIGN_EPI) { if (wr == 1) PG8_BAR; }
    }
    PG8_WAIT_V(0);
    if constexpr (!ALIGN_EPI) { if (wr == 0) PG8_BAR; }
    PG8_BAR;
    if constexpr (Epi::AFTER_DRAIN) { E.fused(acc, cur, wr, wc, fr, fq, lds, wid, lane); S.done(cur); }
#undef PG8_SA
#undef PG8_SB
#undef PG8_STAGE
#undef PG8_LDA
#undef PG8_LDB
#undef PG8_MMA
#undef PG8_WAIT_V
#undef PG8_WAIT_L
#undef PG8_BAR
#undef PG8_SCHED
}
}

constexpr int NWAVES = 8;
constexpr int D = 1024, BATCH = 16, SEQ = 2048, M = BATCH * SEQ, DEPTH = 4;
constexpr int NIN = 6928, NP = 7168;
constexpr int PC_Q = 0, PC_K = 512, PC_V = 1024, PC_G = 2048, PC_GA = 3072, PC_GB = 4096, PC_R = 5120, PC_RK = 5632, PC_RV = 6144, PC_PA = 6656, PC_WD = 6688, PC_AD = 6752, PC_GD = 6816;
constexpr int FFN = 2816, MFF = 3584, NEXP = 8;
constexpr int MOE_ROWS = 2 * M + NEXP * 256;
constexpr float NORM_EPS = 1e-6f;

constexpr size_t MiB = 1u << 20;
constexpr size_t WS_CTL = 0, CTL_ZERO_BYTES = 2 * MiB;
constexpr size_t WS_MODP = 2 * MiB;
constexpr size_t WS_WIN = 8 * MiB, WS_GLAO = 22 * MiB, WS_RWO = 24 * MiB, WS_WOUT = 25 * MiB, WS_WFF = 27 * MiB;
constexpr size_t WS_FUP = WS_WFF, WS_FDN = WS_WFF + 11 * MiB, WS_MUP = WS_WFF, WS_MDN = WS_WFF + 112 * MiB;
constexpr size_t WS_H = 196 * MiB;
constexpr size_t WS_P = 260 * MiB;
constexpr size_t WS_GO = 708 * MiB;
constexpr size_t WS_RR = 772 * MiB, WS_RK = 804 * MiB, WS_RV = 836 * MiB, WS_RA = 868 * MiB, WS_RB = 900 * MiB, WS_RG = 932 * MiB;
constexpr size_t WS_RW = 964 * MiB;
constexpr size_t WS_RY = 1028 * MiB;
constexpr size_t WS_BC = 1060 * MiB;
constexpr size_t WS_MOE = 1061 * MiB;
constexpr size_t WS_END = 1063 * MiB;
constexpr size_t WS_U = WS_P;
constexpr size_t WS_HA = 722 * MiB;
static_assert(WS_U + (size_t)MOE_ROWS * MFF * 2 <= WS_HA && WS_HA + (size_t)MOE_ROWS * D * 2 <= WS_BC, "moe overlay");
constexpr size_t MO_TOPI = 0, MO_TOPW = 256 * 1024, MO_POS = 512 * 1024, MO_CNT = 768 * 1024, MO_TILE = 800 * 1024, MO_NT = 832 * 1024;
constexpr int CW_BAR = 4096;

constexpr int RING_OFF = 0, RING_BYTES = 131072;
constexpr int LDSCTL_OFF = RING_BYTES, MISC_OFF = LDSCTL_OFF + 320;
constexpr int LDS_BYTES = 147456;
static_assert(MISC_OFF + 128 <= LDS_BYTES, "LDS map");

#define GAS __attribute__((address_space(1)))
#define LAS __attribute__((address_space(3)))
typedef unsigned short bf16;
typedef unsigned v4u __attribute__((ext_vector_type(4)));
typedef unsigned v2u __attribute__((ext_vector_type(2)));
typedef float f32x4 __attribute__((ext_vector_type(4)));
#define LDS_WAIT() asm volatile("s_waitcnt lgkmcnt(0)" ::: "memory")
#define VM_WAIT() asm volatile("s_waitcnt vmcnt(0)" ::: "memory")
__device__ __forceinline__ unsigned f2bf(float f) { unsigned u = __builtin_bit_cast(unsigned, f); return (u + 0x7fffu + ((u >> 16) & 1u)) >> 16; }
__device__ __forceinline__ unsigned pk2(float lo, float hi) { return f2bf(lo) | (f2bf(hi) << 16); }
__device__ __forceinline__ float bf2f(bf16 b) { return __uint_as_float(((unsigned)b) << 16); }
__device__ __forceinline__ float blo(unsigned w) { return __uint_as_float(w << 16); }
__device__ __forceinline__ float bhi(unsigned w) { return __uint_as_float(w & 0xffff0000u); }
__device__ __forceinline__ float sigmoidf_(float x) { return 1.0f / (1.0f + __expf(-x)); }
__device__ __forceinline__ float softplusf_(float x) { return fmaxf(x, 0.f) + log1pf(__expf(-fabsf(x))); }
__device__ __forceinline__ float tanhf_(float x) { return 1.0f - 2.0f / (1.0f + __expf(2.0f * x)); }
__device__ __forceinline__ float wave_sum(float v) {
#pragma unroll
    for (int o = 1; o < 64; o <<= 1) v += __shfl_xor(v, o);
    return v;
}

struct Args { const float* in[32]; float* out; unsigned char* ws; int l_lo, l_hi, ph_lo, ph_hi, fused, pad; };
#define XB_TMO      128
#define XB_XCNT(j)  (256  + 64 * (j))
#define XB_XSUB(j)  (1280 + 64 * (j))
#define XB_XGEN(j)  (2304 + 64 * (j))
#define XB_TOP      3328
#define XB_TOPGEN   3392
#define XCD_BAR_WORDS 3456
#define XB_SPIN_CAP (1u << 18)

__device__ __forceinline__ unsigned xb_ld(unsigned* p)              { return __hip_atomic_load(p, __ATOMIC_RELAXED, __HIP_MEMORY_SCOPE_AGENT); }
__device__ __forceinline__ unsigned xb_add(unsigned* p, unsigned v) { return __hip_atomic_fetch_add(p, v, __ATOMIC_RELAXED, __HIP_MEMORY_SCOPE_AGENT); }
__device__ __forceinline__ unsigned xb_xcc_id() { return (unsigned)__builtin_amdgcn_s_getreg((3 << 11) | 20) & 0xFu; }
#define XB_SPIN(cond, bar) do { unsigned _sp = 0; while (cond) { __builtin_amdgcn_s_sleep(1); \
    if ((++_sp & 255u) == 0u) { if (xb_ld(&(bar)[XB_TMO])) break; if (_sp > XB_SPIN_CAP) { atomicAdd(&(bar)[XB_TMO], 1u); break; } } } } while (0)

struct XcdBarrier {
    unsigned* bar; unsigned x;
    volatile LAS unsigned* st;
};

__device__ __forceinline__ XcdBarrier xcd_barrier_post(unsigned* bar, volatile LAS unsigned* st) {
    XcdBarrier b; b.bar = bar; b.x = xb_xcc_id(); b.st = st;
    if (threadIdx.x == 0) (void)xb_add(&bar[XB_XCNT(b.x)], 1u);
    return b;
}
__device__ __forceinline__ void xcd_barrier_complete(unsigned* bar, unsigned x, unsigned& nloc, unsigned& nx) {
    const unsigned G = gridDim.x * gridDim.y * gridDim.z;
    unsigned sum, cnt, mine, sp = 0u;
    for (;;) {
        sum = 0u; cnt = 0u; mine = 0u;
#pragma unroll
        for (unsigned j = 0; j < 16; ++j) { const unsigned c = xb_ld(&bar[XB_XCNT(j)]); sum += c; cnt += (c > 0u) ? 1u : 0u; mine = (j == x) ? c : mine; }
        if (sum == G) break;
        __builtin_amdgcn_s_sleep(1);
        if ((++sp & 255u) == 0u) { if (xb_ld(&bar[XB_TMO])) break; if (sp > XB_SPIN_CAP) { atomicAdd(&bar[XB_TMO], 1u); break; } }
    }
    nloc = mine > 0u ? mine : 1u; nx = cnt > 0u ? cnt : 1u;
}

__device__ __forceinline__ void xcd_barrier(const XcdBarrier& b) {
    asm volatile("s_waitcnt vmcnt(0)" ::: "memory");
    __syncthreads();
    if (threadIdx.x == 0) {
        unsigned* bar = b.bar;
        __builtin_amdgcn_s_waitcnt(0);
        unsigned nloc = b.st[0], nx = b.st[1];
        if (nloc == 0u) { xcd_barrier_complete(bar, b.x, nloc, nx); b.st[0] = nloc; b.st[1] = nx; }
        const unsigned old = xb_add(&bar[XB_XSUB(b.x)], 1u);
        const unsigned gen = old / nloc;
        if (old + 1u == (gen + 1u) * nloc) {
            __builtin_amdgcn_fence(__ATOMIC_RELEASE, "agent");
            asm volatile("s_waitcnt vmcnt(0)" ::: "memory");
            const unsigned og = xb_add(&bar[XB_TOP], 1u);
            const unsigned tg = og / nx;
            if (og + 1u == (tg + 1u) * nx) xb_add(&bar[XB_TOPGEN], 1u);
            else XB_SPIN(xb_ld(&bar[XB_TOPGEN]) == tg, bar);
            __builtin_amdgcn_fence(__ATOMIC_ACQUIRE, "agent");
            xb_add(&bar[XB_XGEN(b.x)], 1u);
            asm volatile("s_waitcnt vmcnt(0)" ::: "memory");
        } else {
            XB_SPIN(xb_ld(&bar[XB_XGEN(b.x)]) == gen, bar);
            __builtin_amdgcn_fence(__ATOMIC_ACQUIRE, "agent");
            asm volatile("s_waitcnt vmcnt(0)" ::: "memory");
        }
    }
    __syncthreads();
}

struct Frame {
    LAS unsigned char* lds;
    volatile LAS unsigned* MISC;
    int tid, lane, wave, vcu, G;
    float* out; unsigned char* ws;
};
#define WSP(T, off) ((T*)(F.ws + (off)))

__device__ __forceinline__ f32x4 mod4(const Frame& F, const Args& A, int l, int b, int j) {
    f32x4 v = *(const f32x4*)(A.in[3] + (size_t)l * 6144 + j);
    const float* mp = WSP(const float, WS_MODP);
#pragma unroll
    for (int q = 0; q < 4; ++q) v += *(const f32x4*)(mp + ((size_t)((q * 4 + l) * 16 + b)) * 6144 + j);
    return v;
}

__device__ __forceinline__ void phase_mod(Frame& F, const Args& A) {
    if (blockIdx.x < 192) {
        LAS float* sC = (LAS float*)F.lds;
        const int idx = blockIdx.x * 512 + F.tid, j = idx % 6144, ql = idx / 6144, l = ql & 3, q = ql >> 2;
        const float* c = A.in[1];
        for (int i = F.tid; i < 16 * 256; i += 512) { const int b = i >> 8, k = i & 255; const float cv = c[b * 1024 + q * 256 + k]; sC[i] = cv * sigmoidf_(cv); }
        __syncthreads();
        float acc[16];
#pragma unroll
        for (int b = 0; b < 16; ++b) acc[b] = 0.f;
        const float* wp = A.in[2] + ((size_t)l * 1024 + q * 256) * 6144 + j;
        for (int k = 0; k < 256; ++k) { const float wv = wp[(size_t)k * 6144];
#pragma unroll
            for (int b = 0; b < 16; ++b) acc[b] += sC[b * 256 + k] * wv; }
        float* mp = WSP(float, WS_MODP);
#pragma unroll
        for (int b = 0; b < 16; ++b) mp[((size_t)((q * 4 + l) * 16 + b)) * 6144 + j] = acc[b];
    }
    __syncthreads();
}

__device__ __forceinline__ void transpose_item(const float* src, int ldsrc, int k0, int srccol, bf16* dst, int lddst, int drow0, LAS float* scr, int lane) {
#pragma unroll 8
    for (int i = 0; i < 32; ++i) { const int kk = 2 * i + (lane >> 5); scr[kk * 33 + (lane & 31)] = srccol >= 0 ? src[(size_t)(k0 + kk) * ldsrc + srccol] : 0.f; }
    LDS_WAIT(); asm volatile("" ::: "memory");
    const int c = lane & 7;
#pragma unroll
    for (int j = 0; j < 4; ++j) { const int n = (lane >> 3) + 8 * j; const LAS float* s = scr + (8 * c) * 33 + n;
        v4u o; o.x = pk2(s[0 * 33], s[1 * 33]); o.y = pk2(s[2 * 33], s[3 * 33]); o.z = pk2(s[4 * 33], s[5 * 33]); o.w = pk2(s[6 * 33], s[7 * 33]);
        *(v4u*)(dst + (size_t)(drow0 + n) * lddst + k0 + 8 * c) = o; }
    LDS_WAIT(); asm volatile("" ::: "memory");
}
__device__ __forceinline__ int win_srccol(int n) {
    if (n < 3072) return n;
    if (n < 4096) return 4880 + (n - 3072);
    if (n < 5120) return 5904 + (n - 4096);
    if (n < 5632) return 3088 + (n - 5120);
    if (n < 6144) return 3664 + (n - 5632);
    if (n < 6656) return 4176 + (n - 6144);
    if (n < 6672) return 3072 + (n - 6656);
    if (n < 6688) return -1;
    if (n < 6752) return 3600 + (n - 6688);
    if (n < 6816) return 4688 + (n - 6752);
    if (n < 6944) return 4752 + (n - 6816);
    return -1;
}
__device__ __forceinline__ void phase_conv(Frame& F, const Args& A, int l) {
    LAS float* scr = (LAS float*)(F.lds + RING_OFF + F.wave * 16384);
    const int gw = F.vcu * NWAVES + F.wave, NGW = F.G * NWAVES, lane = F.lane, l31 = lane & 31;
    constexpr int I_IN = 16 * 224, I_GO = 16 * 32, I_RO = 8 * 32, I_WO = 16 * 32;
    constexpr int I_FU = 16 * 176, I_FD = 44 * 32, I_MU = 8 * 16 * 224, I_MD = 8 * 56 * 32;
    const bool moe = (l & 1);
    const int nitems = I_IN + I_GO + I_RO + I_WO + (moe ? (I_MU + I_MD) : (I_FU + I_FD));
    for (int it = gw; it < nitems; it += NGW) {
        int r = it;
        if (r < I_IN) { const int kb = r / 224, nb = r % 224; transpose_item(A.in[6] + (size_t)l * 1024 * NIN, NIN, kb * 64, win_srccol(nb * 32 + l31), WSP(bf16, WS_WIN), 1024, nb * 32, scr, lane); continue; } r -= I_IN;
        if (r < I_GO) { const int kb = r / 32, nb = r % 32; transpose_item(A.in[10] + (size_t)l * 1024 * 1024, 1024, kb * 64, nb * 32 + l31, WSP(bf16, WS_GLAO), 1024, nb * 32, scr, lane); continue; } r -= I_GO;
        if (r < I_RO) { const int kb = r / 32, nb = r % 32; transpose_item(A.in[22] + (size_t)l * 512 * 1024, 1024, kb * 64, nb * 32 + l31, WSP(bf16, WS_RWO), 512, nb * 32, scr, lane); continue; } r -= I_RO;
        if (r < I_WO) { const int kb = r / 32, nb = r % 32; transpose_item(A.in[23] + (size_t)l * 1024 * 1024, 1024, kb * 64, nb * 32 + l31, WSP(bf16, WS_WOUT), 1024, nb * 32, scr, lane); continue; } r -= I_WO;
        if (!moe) {
            const int li = l >> 1;
            if (r < I_FU) { const int kb = r / 176, nb = r % 176, n0 = nb * 32, pn = n0 >> 8, within = n0 & 255;
                const float* src = (within < 128 ? A.in[24] : A.in[25]) + (size_t)li * 1024 * FFN;
                transpose_item(src, FFN, kb * 64, pn * 128 + (within & 127) + l31, WSP(bf16, WS_FUP), 1024, n0, scr, lane); continue; } r -= I_FU;
            { const int kb = r / 32, nb = r % 32; transpose_item(A.in[26] + (size_t)li * FFN * 1024, 1024, kb * 64, nb * 32 + l31, WSP(bf16, WS_FDN), FFN, nb * 32, scr, lane); }
        } else {
            const int li = l >> 1;
            if (r < I_MU) { const int e = r / (16 * 224), rr = r % (16 * 224), kb = rr / 224, nb = rr % 224, n0 = nb * 32, pn = n0 >> 8, within = n0 & 255;
                const float* src = (within < 128 ? A.in[28] : A.in[29]) + ((size_t)(li * 8 + e)) * 1024 * MFF;
                transpose_item(src, MFF, kb * 64, pn * 128 + (within & 127) + l31, WSP(bf16, WS_MUP) + (size_t)e * 7168 * 1024, 1024, n0, scr, lane); continue; } r -= I_MU;
            { const int e = r / (56 * 32), rr = r % (56 * 32), kb = rr / 32, nb = rr % 32;
                transpose_item(A.in[30] + ((size_t)(li * 8 + e)) * MFF * 1024, 1024, kb * 64, nb * 32 + l31, WSP(bf16, WS_MDN) + (size_t)e * 1024 * MFF, MFF, nb * 32, scr, lane); }
        }
    }
}

template <int WHICH>
__device__ __forceinline__ void phase_norm(Frame& F, const Args& A, int l, const float* xin) {
    const int gw = F.vcu * NWAVES + F.wave, lane = F.lane, row0 = gw * 16, b = row0 >> 11;
    const float* gain = (WHICH == 0 ? A.in[4] : A.in[5]) + (size_t)l * 1024;
    const int jsh = (WHICH == 0 ? 0 : 3072), jsc = jsh + 1024;
    f32x4 g[4], sc[4], sh[4];
#pragma unroll
    for (int j = 0; j < 4; ++j) { const int c = 4 * lane + 256 * j; g[j] = *(const f32x4*)(gain + c); sc[j] = mod4(F, A, l, b, jsc + c) + 1.0f; sh[j] = mod4(F, A, l, b, jsh + c); g[j] = g[j] * sc[j]; }
    LAS float* sR = (LAS float*)F.lds;
    LAS int* sCnt = (LAS int*)(F.lds + 32768);
    if (WHICH == 2) {
        const float* rt = A.in[27] + (size_t)(l >> 1) * 1024 * 8;
        for (int i = F.tid; i < 8192; i += 512) sR[i] = rt[i];
        if (F.tid < 8) sCnt[F.tid] = 0;
        __syncthreads();
    }
    bf16* H = WSP(bf16, WS_H);
    for (int rr = 0; rr < 16; ++rr) {
        const int m = row0 + rr;
        f32x4 x[4]; float ss = 0.f;
#pragma unroll
        for (int j = 0; j < 4; ++j) { x[j] = *(const f32x4*)(xin + (size_t)m * 1024 + 4 * lane + 256 * j); ss += (x[j].x * x[j].x + x[j].y * x[j].y) + (x[j].z * x[j].z + x[j].w * x[j].w); }
        const float rs = 1.0f / sqrtf(wave_sum(ss) * (1.0f / 1024.0f) + NORM_EPS);
#pragma unroll
        for (int j = 0; j < 4; ++j) { x[j] = (x[j] * rs) * g[j] + sh[j];
            v2u o; o.x = pk2(x[j].x, x[j].y); o.y = pk2(x[j].z, x[j].w);
            *(v2u*)(H + (size_t)m * 1024 + 4 * lane + 256 * j) = o; }
        if (WHICH == 2) {
            float lg[8];
#pragma unroll
            for (int e = 0; e < 8; ++e) lg[e] = 0.f;
#pragma unroll
            for (int j = 0; j < 4; ++j)
#pragma unroll
                for (int i = 0; i < 4; ++i) { const int c = 4 * lane + 256 * j + i; const f32x4 r0 = *(const LAS f32x4*)(sR + c * 8), r1 = *(const LAS f32x4*)(sR + c * 8 + 4); const float xv = x[j][i];
                    lg[0] += xv * r0.x; lg[1] += xv * r0.y; lg[2] += xv * r0.z; lg[3] += xv * r0.w; lg[4] += xv * r1.x; lg[5] += xv * r1.y; lg[6] += xv * r1.z; lg[7] += xv * r1.w; }
#pragma unroll
            for (int e = 0; e < 8; ++e) lg[e] = wave_sum(lg[e]);
            if (lane == 0) {
                int i1 = 0; float v1 = lg[0];
#pragma unroll
                for (int e = 1; e < 8; ++e) if (lg[e] > v1) { v1 = lg[e]; i1 = e; }
                int i2 = -1; float v2 = -3.0e38f;
#pragma unroll
                for (int e = 0; e < 8; ++e) if (e != i1 && lg[e] > v2) { v2 = lg[e]; i2 = e; }
                const float w2 = 1.0f / (1.0f + __expf(v1 - v2)), w1 = 1.0f - w2;
                int* topi = (int*)(F.ws + WS_MOE + MO_TOPI); float* topw = (float*)(F.ws + WS_MOE + MO_TOPW);
                topi[2 * m] = i1; topi[2 * m + 1] = i2; topw[2 * m] = w1; topw[2 * m + 1] = w2;
                atomicAdd((int*)&sCnt[i1], 1); atomicAdd((int*)&sCnt[i2], 1);
            }
        }
    }
    if (WHICH == 2) {
        __syncthreads();
        if (F.tid < 8) ((int*)(F.ws + WS_MOE + MO_CNT))[F.vcu * 8 + F.tid] = sCnt[F.tid];
        __syncthreads();
    }
}

__device__ __forceinline__ void phase_route2(Frame& F, const Args& A) {
    LAS int* sI = (LAS int*)F.lds;
    const int* cnt = (const int*)(F.ws + WS_MOE + MO_CNT);
    const int* topi = (const int*)(F.ws + WS_MOE + MO_TOPI);
    int* pos = (int*)(F.ws + WS_MOE + MO_POS);
    const int wgi = F.vcu, m0 = wgi * 128;
    if (F.tid < 8) { int tot = 0, pre = 0; for (int w = 0; w < 256; ++w) { const int c = cnt[w * 8 + F.tid]; tot += c; pre += (w < wgi) ? c : 0; } sI[F.tid] = tot; sI[8 + F.tid] = pre; }
    __syncthreads();
    if (F.tid == 0) { int base = 0; for (int e = 0; e < 8; ++e) { sI[16 + e] = base; base += ((sI[e] + 255) >> 8) << 8; } sI[24] = base; }
    __syncthreads();
    if (F.tid < 8) { const int e = F.tid; int slot = sI[16 + e] + sI[8 + e];
        for (int i = 0; i < 256; ++i) { if (topi[2 * m0 + i] == e) { sI[32 + i] = slot; pos[2 * m0 + i] = slot; ++slot; } } }
    if (wgi == 0 && F.tid >= 64 && F.tid < 64 + 264) {
        const int t = F.tid - 64; int e = 0;
#pragma unroll
        for (int k = 1; k < 8; ++k) if (t * 256 >= sI[16 + k]) e = k;
        ((int*)(F.ws + WS_MOE + MO_TILE))[t] = e;
        if (t == 0) ((int*)(F.ws + WS_MOE + MO_NT))[0] = sI[24] >> 8;
    }
    __syncthreads();
    const bf16* H = WSP(const bf16, WS_H); bf16* HA = WSP(bf16, WS_HA);
    for (int p = F.wave * 32; p < F.wave * 32 + 32; ++p) { const int slot = sI[32 + p], m = m0 + (p >> 1);
        const v4u a = *(const v4u*)(H + (size_t)m * 1024 + F.lane * 16), b = *(const v4u*)(H + (size_t)m * 1024 + F.lane * 16 + 8);
        *(v4u*)(HA + (size_t)slot * 1024 + F.lane * 16) = a; *(v4u*)(HA + (size_t)slot * 1024 + F.lane * 16 + 8) = b; }
    if (wgi < 8) { const int lo = sI[16 + wgi] + sI[wgi], hi = sI[16 + wgi + 1];
        const v4u z = {0u, 0u, 0u, 0u};
        for (int r = lo + F.wave; r < hi; r += NWAVES) { *(v4u*)(HA + (size_t)r * 1024 + F.lane * 16) = z; *(v4u*)(HA + (size_t)r * 1024 + F.lane * 16 + 8) = z; } }
    __syncthreads();
}

__device__ __forceinline__ void phase_combine(Frame& F, const Args& A, int l) {
    const int gw = F.vcu * NWAVES + F.wave, lane = F.lane, row0 = gw * 16, b = row0 >> 11;
    f32x4 g2[4];
#pragma unroll
    for (int j = 0; j < 4; ++j) g2[j] = mod4(F, A, l, b, 5120 + 4 * lane + 256 * j);
    const int* pos = (const int*)(F.ws + WS_MOE + MO_POS); const float* topw = (const float*)(F.ws + WS_MOE + MO_TOPW);
    const bf16* YP = WSP(const bf16, WS_HA);
    for (int rr = 0; rr < 16; ++rr) { const int m = row0 + rr; const int p1 = pos[2 * m], p2 = pos[2 * m + 1]; const float w1 = topw[2 * m], w2 = topw[2 * m + 1];
#pragma unroll
        for (int j = 0; j < 4; ++j) { const int c = 4 * lane + 256 * j; const v2u a = *(const v2u*)(YP + (size_t)p1 * 1024 + c), bb = *(const v2u*)(YP + (size_t)p2 * 1024 + c);
            f32x4 y; y.x = w1 * blo(a.x) + w2 * blo(bb.x); y.y = w1 * bhi(a.x) + w2 * bhi(bb.x); y.z = w1 * blo(a.y) + w2 * blo(bb.y); y.w = w1 * bhi(a.y) + w2 * bhi(bb.y);
            float* xp = F.out + (size_t)m * 1024 + c; *(f32x4*)xp = *(const f32x4*)xp + g2[j] * y; } }
}

__device__ __forceinline__ void phase_final(Frame& F, const Args& A) {
    const int gw = F.vcu * NWAVES + F.wave, lane = F.lane, row0 = gw * 16;
    f32x4 g[4];
#pragma unroll
    for (int j = 0; j < 4; ++j) g[j] = *(const f32x4*)(A.in[31] + 4 * lane + 256 * j);
    for (int rr = 0; rr < 16; ++rr) { const int m = row0 + rr; f32x4 x[4]; float ss = 0.f;
#pragma unroll
        for (int j = 0; j < 4; ++j) { x[j] = *(const f32x4*)(F.out + (size_t)m * 1024 + 4 * lane + 256 * j); ss += (x[j].x * x[j].x + x[j].y * x[j].y) + (x[j].z * x[j].z + x[j].w * x[j].w); }
        const float rs = 1.0f / sqrtf(wave_sum(ss) * (1.0f / 1024.0f) + NORM_EPS);
#pragma unroll
        for (int j = 0; j < 4; ++j) *(f32x4*)(F.out + (size_t)m * 1024 + 4 * lane + 256 * j) = (x[j] * rs) * g[j]; }
}

__device__ __forceinline__ void phase_gla_prep(Frame& F, const Args& A, int l) {
    const int gw = F.vcu * NWAVES + F.wave, lane = F.lane, row0 = gw * 16, c0 = lane * 8;
    const float* au = A.in[7] + (size_t)l * 16 * 512; const float* ab = A.in[8] + (size_t)l * 512;
    f32x4 w[16][2];
#pragma unroll
    for (int r = 0; r < 16; ++r) { w[r][0] = *(const f32x4*)(au + r * 512 + c0); w[r][1] = *(const f32x4*)(au + r * 512 + c0 + 4); }
    const f32x4 b0 = *(const f32x4*)(ab + c0), b1 = *(const f32x4*)(ab + c0 + 4);
    const bf16* P = WSP(const bf16, WS_P); float* LA = WSP(float, WS_H);
    for (int rr = 0; rr < 16; ++rr) { const int m = row0 + rr;
        const v4u p0 = *(const v4u*)(P + (size_t)m * NP + PC_PA), p1 = *(const v4u*)(P + (size_t)m * NP + PC_PA + 8);
        float pa[16] = {blo(p0.x), bhi(p0.x), blo(p0.y), bhi(p0.y), blo(p0.z), bhi(p0.z), blo(p0.w), bhi(p0.w), blo(p1.x), bhi(p1.x), blo(p1.y), bhi(p1.y), blo(p1.z), bhi(p1.z), blo(p1.w), bhi(p1.w)};
        f32x4 z0 = b0, z1 = b1;
#pragma unroll
        for (int r = 0; r < 16; ++r) { z0 += w[r][0] * pa[r]; z1 += w[r][1] * pa[r]; }
        f32x4 o0, o1;
#pragma unroll
        for (int i = 0; i < 4; ++i) { o0[i] = -softplusf_(-z0[i]) * 0.0625f; o1[i] = -softplusf_(-z1[i]) * 0.0625f; }
        *(f32x4*)(LA + (size_t)m * 512 + c0) = o0; *(f32x4*)(LA + (size_t)m * 512 + c0 + 4) = o1; }
}

__device__ __forceinline__ void phase_gla_scan_ref(Frame& F, const Args& A) {
    const int wgi = F.vcu, b = wgi >> 4, h = (wgi >> 2) & 3, vq = wgi & 3, w = F.wave, lane = F.lane, tid = F.tid;
    LAS float* sQ = (LAS float*)F.lds; LAS float* sK = sQ + 2048; LAS float* sA = sK + 2048; LAS float* sO = sA + 2048;
    const bf16* P = WSP(const bf16, WS_P); const float* LA = WSP(const float, WS_H); bf16* GO = WSP(bf16, WS_GO);
    float S[16];
#pragma unroll
    for (int i = 0; i < 16; ++i) S[i] = 0.f;
    const float scale = 0.08838834764831845f;
    for (int tb = 0; tb < 128; ++tb) {
        const int m0 = b * 2048 + tb * 16;
#pragma unroll
        for (int i = 0; i < 4; ++i) { const int idx = tid + 512 * i, t = idx >> 7, d = idx & 127; const size_t m = (size_t)(m0 + t);
            sQ[idx] = bf2f(P[m * NP + PC_Q + h * 128 + d]) * scale; sK[idx] = bf2f(P[m * NP + PC_K + h * 128 + d]); sA[idx] = __expf(LA[m * 512 + h * 128 + d]); }
        float vv[16];
#pragma unroll
        for (int t = 0; t < 16; ++t) vv[t] = bf2f(P[(size_t)(m0 + t) * NP + PC_V + h * 256 + vq * 64 + lane]);
        __syncthreads();
#pragma unroll
        for (int t = 0; t < 16; ++t) { float o = 0.f;
#pragma unroll
            for (int dd = 0; dd < 16; ++dd) { const int d = 16 * w + dd; S[dd] = sA[t * 128 + d] * S[dd] + sK[t * 128 + d] * vv[t]; o += sQ[t * 128 + d] * S[dd]; }
            sO[(w * 16 + t) * 64 + lane] = o; }
        __syncthreads();
#pragma unroll
        for (int i = 0; i < 2; ++i) { const int idx = tid + 512 * i, t = idx >> 6, v = idx & 63; float o = 0.f;
#pragma unroll
            for (int ww = 0; ww < 8; ++ww) o += sO[(ww * 16 + t) * 64 + v];
            GO[(size_t)(m0 + t) * 1024 + h * 256 + vq * 64 + v] = (bf16)f2bf(o); }
        __syncthreads();
    }
}

__device__ __forceinline__ void phase_rwkv_prep(Frame& F, const Args& A, int l) {
    const int wgi = F.vcu, tid = F.tid, c = tid, lane = F.lane, head = F.wave;
    LAS float* sS = (LAS float*)F.lds;
    const bf16* P = WSP(const bf16, WS_P);
    const float* mu = A.in[11] + (size_t)l * 1792;
    const float* w2 = A.in[13] + (size_t)l * 64 * 512; const float* a2 = A.in[15] + (size_t)l * 64 * 512; const float* g2 = A.in[16] + (size_t)l * 128 * 512;
    const float w0 = A.in[12][l * 512 + c], a0 = A.in[14][l * 512 + c], kkc = A.in[17][l * 512 + c], kac = A.in[18][l * 512 + c], rkc = A.in[19][l * 512 + c];
    const float mu_r = mu[c], mu_k = mu[576 + c], mu_v = mu[1088 + c];
    bf16* RR = WSP(bf16, WS_RR); bf16* RK = WSP(bf16, WS_RK); bf16* RV = WSP(bf16, WS_RV); bf16* RA = WSP(bf16, WS_RA); bf16* RB = WSP(bf16, WS_RB); bf16* RG = WSP(bf16, WS_RG);
    float* RW = WSP(float, WS_RW); float* BC = WSP(float, WS_BC);
    for (int tile = 0; tile < 16; ++tile) {
        const int m0 = wgi * 128 + tile * 8;
#pragma unroll
        for (int i = 0; i < 4; ++i) { const int idx = tid + 512 * i, tk = idx >> 8, sc = idx & 255; const int m = m0 + tk;
            int pc, mi; if (sc < 64) { pc = PC_WD + sc; mi = 512 + sc; } else if (sc < 128) { pc = PC_AD + (sc - 64); mi = 1600 + (sc - 64); } else { pc = PC_GD + (sc - 128); mi = 1664 + (sc - 128); }
            const float cur = bf2f(P[(size_t)m * NP + pc]); const float prv = (m & 2047) ? bf2f(P[(size_t)(m - 1) * NP + pc]) : 0.f;
            const float xs = cur + (prv - cur) * mu[mi];
            sS[idx] = sc < 64 ? tanhf_(xs) : (sc < 128 ? xs : sigmoidf_(xs)); }
        __syncthreads();
        float aw[8], aa[8], ag[8];
#pragma unroll
        for (int i = 0; i < 8; ++i) { aw[i] = 0.f; aa[i] = 0.f; ag[i] = 0.f; }
        for (int r = 0; r < 64; ++r) { const float wv = w2[r * 512 + c], av = a2[r * 512 + c];
#pragma unroll
            for (int i = 0; i < 8; ++i) { aw[i] += sS[i * 256 + r] * wv; aa[i] += sS[i * 256 + 64 + r] * av; } }
        for (int r = 0; r < 128; ++r) { const float gv = g2[r * 512 + c];
#pragma unroll
            for (int i = 0; i < 8; ++i) ag[i] += sS[i * 256 + 128 + r] * gv; }
#pragma unroll
        for (int i = 0; i < 8; ++i) { const int m = m0 + i; const bool first = (m & 2047) == 0;
            const float cr = bf2f(P[(size_t)m * NP + PC_R + c]), ck = bf2f(P[(size_t)m * NP + PC_RK + c]), cv = bf2f(P[(size_t)m * NP + PC_RV + c]);
            const float pr = first ? 0.f : bf2f(P[(size_t)(m - 1) * NP + PC_R + c]), pk = first ? 0.f : bf2f(P[(size_t)(m - 1) * NP + PC_RK + c]), pv = first ? 0.f : bf2f(P[(size_t)(m - 1) * NP + PC_RV + c]);
            const float r = cr + (pr - cr) * mu_r, k = ck + (pk - ck) * mu_k, v = cv + (pv - cv) * mu_v;
            const float wl = -softplusf_(-(w0 + aw[i])) - 0.5f; const float decay = __expf(-__expf(wl));
            const float a = sigmoidf_(a0 + aa[i]); const float g = ag[i];
            const float kk = k * kkc; const float nrm = fmaxf(sqrtf(wave_sum(kk * kk)), 1e-12f); const float kkn = kk / nrm;
            const float km = k * (1.0f + (a - 1.0f) * kac);
            const float bc = wave_sum(r * km * rkc);
            const size_t o = (size_t)m * 512 + c;
            RR[o] = (bf16)f2bf(r); RK[o] = (bf16)f2bf(km); RV[o] = (bf16)f2bf(v); RA[o] = (bf16)f2bf(-kkn); RB[o] = (bf16)f2bf(kkn * a); RG[o] = (bf16)f2bf(g); RW[o] = decay;
            if (lane == 0) BC[(size_t)m * 8 + head] = bc; }
        __syncthreads();
    }
}

template <int CTRL> __device__ __forceinline__ float dpp_add(float x) { return x + __builtin_bit_cast(float, __builtin_amdgcn_update_dpp(0, __builtin_bit_cast(int, x), CTRL, 0xf, 0xf, false)); }
__device__ __forceinline__ float allreduce16(float x) { x = dpp_add<0x128>(x); x = dpp_add<0x124>(x); x = dpp_add<0x122>(x); x = dpp_add<0x121>(x); return x; }
__device__ __forceinline__ void phase_rwkv_scan(Frame& F, const Args& A) {
    constexpr int TB = 32, STEP = 352;
    const int wgi = F.vcu, bh = wgi >> 1, rh = wgi & 1, b = bh >> 3, h = bh & 7, tid = F.tid, row = tid >> 4, ks = tid & 15;
    LAS float* sm = (LAS float*)F.lds; LAS float* sY = sm + TB * STEP;
    const bf16* RR = WSP(const bf16, WS_RR); const bf16* RK = WSP(const bf16, WS_RK); const bf16* RV = WSP(const bf16, WS_RV); const bf16* RA = WSP(const bf16, WS_RA); const bf16* RB = WSP(const bf16, WS_RB);
    const float* RW = WSP(const float, WS_RW); bf16* RY = WSP(bf16, WS_RY);
    float S0 = 0.f, S1 = 0.f, S2 = 0.f, S3 = 0.f;
    for (int blk = 0; blk < SEQ / TB; ++blk) {
        const int m0 = b * SEQ + blk * TB;
#pragma unroll
        for (int i = 0; i < 22; ++i) { const int idx = tid + 512 * i; float val; int t, off;
            if (idx < 10240) { const int arr = idx >> 11, rem = idx & 2047; t = rem >> 6; const int cc = rem & 63; const size_t g = (size_t)(m0 + t) * 512 + h * 64 + cc; off = arr * 64 + cc;
                val = arr == 0 ? bf2f(RR[g]) : arr == 1 ? RW[g] : arr == 2 ? bf2f(RK[g]) : arr == 3 ? bf2f(RA[g]) : bf2f(RB[g]); }
            else { const int rem = idx - 10240; t = rem >> 5; const int rw = rem & 31; off = 320 + rw; val = bf2f(RV[(size_t)(m0 + t) * 512 + h * 64 + rh * 32 + rw]); }
            sm[t * STEP + off] = val; }
        __syncthreads();
        for (int t = 0; t < TB; ++t) {
            const LAS float* st = sm + t * STEP;
            const f32x4 a4 = *(const LAS f32x4*)(st + 192 + 4 * ks);
            const float sa = allreduce16((S0 * a4.x + S1 * a4.y) + (S2 * a4.z + S3 * a4.w));
            const f32x4 w4 = *(const LAS f32x4*)(st + 64 + 4 * ks), b4 = *(const LAS f32x4*)(st + 256 + 4 * ks), k4 = *(const LAS f32x4*)(st + 128 + 4 * ks), r4 = *(const LAS f32x4*)(st + 4 * ks);
            const float vv = st[320 + row];
            S0 = S0 * w4.x + (sa * b4.x + vv * k4.x); S1 = S1 * w4.y + (sa * b4.y + vv * k4.y); S2 = S2 * w4.z + (sa * b4.z + vv * k4.z); S3 = S3 * w4.w + (sa * b4.w + vv * k4.w);
            const float y = allreduce16((S0 * r4.x + S1 * r4.y) + (S2 * r4.z + S3 * r4.w));
            if (ks == 0) sY[t * 32 + row] = y;
        }
        __syncthreads();
#pragma unroll
        for (int i = 0; i < 2; ++i) { const int idx = tid + 512 * i, t = idx >> 5, rw = idx & 31; RY[(size_t)(m0 + t) * 512 + h * 64 + rh * 32 + rw] = (bf16)f2bf(sY[idx]); }
        __syncthreads();
    }
}

__device__ __forceinline__ void phase_post(Frame& F, const Args& A, int l) {
    const int gw = F.vcu * NWAVES + F.wave, lane = F.lane, row0 = gw * 16;
    const bf16* P = WSP(const bf16, WS_P); bf16* GO = WSP(bf16, WS_GO); bf16* RY = WSP(bf16, WS_RY);
    const bf16* RV = WSP(const bf16, WS_RV); const bf16* RG = WSP(const bf16, WS_RG); const float* BC = WSP(const float, WS_BC);
    float ng[16];
    { const float* p = A.in[9] + (size_t)l * 1024 + 16 * lane;
#pragma unroll
      for (int i = 0; i < 4; ++i) { const f32x4 v = *(const f32x4*)(p + 4 * i); ng[4 * i] = v.x; ng[4 * i + 1] = v.y; ng[4 * i + 2] = v.z; ng[4 * i + 3] = v.w; } }
    float lg[8], lb[8];
    { const float* p = A.in[20] + (size_t)l * 512 + 8 * lane; const float* q = A.in[21] + (size_t)l * 512 + 8 * lane;
#pragma unroll
      for (int i = 0; i < 8; ++i) { lg[i] = p[i]; lb[i] = q[i]; } }
    for (int rr = 0; rr < 16; ++rr) { const size_t m = (size_t)(row0 + rr);
        { bf16* gp = GO + m * 1024 + 16 * lane; const bf16* pg = P + m * NP + PC_G + 16 * lane;
          const v4u a = *(const v4u*)gp, b = *(const v4u*)(gp + 8), ga = *(const v4u*)pg, gb = *(const v4u*)(pg + 8);
          float o[16] = {blo(a.x), bhi(a.x), blo(a.y), bhi(a.y), blo(a.z), bhi(a.z), blo(a.w), bhi(a.w), blo(b.x), bhi(b.x), blo(b.y), bhi(b.y), blo(b.z), bhi(b.z), blo(b.w), bhi(b.w)};
          float g[16] = {blo(ga.x), bhi(ga.x), blo(ga.y), bhi(ga.y), blo(ga.z), bhi(ga.z), blo(ga.w), bhi(ga.w), blo(gb.x), bhi(gb.x), blo(gb.y), bhi(gb.y), blo(gb.z), bhi(gb.z), blo(gb.w), bhi(gb.w)};
          float ss = 0.f;
#pragma unroll
          for (int i = 0; i < 16; ++i) ss += o[i] * o[i];
          ss += __shfl_xor(ss, 1); ss += __shfl_xor(ss, 2); ss += __shfl_xor(ss, 4); ss += __shfl_xor(ss, 8);
          const float rs = 1.0f / sqrtf(ss * (1.0f / 256.0f) + 1e-5f);
#pragma unroll
          for (int i = 0; i < 16; ++i) o[i] = o[i] * rs * ng[i] * (g[i] * sigmoidf_(g[i]));
          v4u w0, w1; w0.x = pk2(o[0], o[1]); w0.y = pk2(o[2], o[3]); w0.z = pk2(o[4], o[5]); w0.w = pk2(o[6], o[7]); w1.x = pk2(o[8], o[9]); w1.y = pk2(o[10], o[11]); w1.z = pk2(o[12], o[13]); w1.w = pk2(o[14], o[15]);
          *(v4u*)gp = w0; *(v4u*)(gp + 8) = w1; }
        { bf16* yp = RY + m * 512 + 8 * lane; const v4u a = *(const v4u*)yp, vv = *(const v4u*)(RV + m * 512 + 8 * lane), gg = *(const v4u*)(RG + m * 512 + 8 * lane);
          float y[8] = {blo(a.x), bhi(a.x), blo(a.y), bhi(a.y), blo(a.z), bhi(a.z), blo(a.w), bhi(a.w)};
          float v[8] = {blo(vv.x), bhi(vv.x), blo(vv.y), bhi(vv.y), blo(vv.z), bhi(vv.z), blo(vv.w), bhi(vv.w)};
          float g[8] = {blo(gg.x), bhi(gg.x), blo(gg.y), bhi(gg.y), blo(gg.z), bhi(gg.z), blo(gg.w), bhi(gg.w)};
          float s = 0.f;
#pragma unroll
          for (int i = 0; i < 8; ++i) s += y[i];
          s += __shfl_xor(s, 1); s += __shfl_xor(s, 2); s += __shfl_xor(s, 4);
          const float mean = s * (1.0f / 64.0f); float q = 0.f;
#pragma unroll
          for (int i = 0; i < 8; ++i) { y[i] -= mean; q += y[i] * y[i]; }
          q += __shfl_xor(q, 1); q += __shfl_xor(q, 2); q += __shfl_xor(q, 4);
          const float rs = 1.0f / sqrtf(q * (1.0f / 64.0f) + 64e-5f);
          const float bc = BC[m * 8 + (lane >> 3)];
#pragma unroll
          for (int i = 0; i < 8; ++i) y[i] = (y[i] * rs * lg[i] + lb[i] + bc * v[i]) * g[i];
          v4u w; w.x = pk2(y[0], y[1]); w.y = pk2(y[2], y[3]); w.z = pk2(y[4], y[5]); w.w = pk2(y[6], y[7]);
          *(v4u*)yp = w; }
    }
}

enum Phase { PH_CONV = 0, PH_NORM1, PH_GEMM_IN, PH_PREP, PH_GLASCAN, PH_RWSCAN, PH_POST, PH_GEMM_GLAO, PH_GEMM_RWO, PH_GEMM_OUT, PH_NORM2, PH_ROUTE2, PH_GEMM_UP, PH_GEMM_DN, PH_COMBINE, PH_FINAL, PH_COUNT };

__global__ void __launch_bounds__(NWAVES * 64, 2) mk_fwd(Args args) {
    extern __shared__ __attribute__((aligned(16))) unsigned char lds[];
    Frame F;
    F.lds = (LAS unsigned char*)lds;
    F.MISC = (volatile LAS unsigned*)(F.lds + MISC_OFF);
    F.tid = threadIdx.x; F.lane = F.tid & 63; F.wave = __builtin_amdgcn_readfirstlane(F.tid >> 6);
    F.G = gridDim.x; { const int bx = blockIdx.x; F.vcu = (F.G % 8 == 0) ? (bx % 8) * (F.G / 8) + bx / 8 : bx; }
    F.out = args.out; F.ws = args.ws;
    for (int u = F.tid; u < (LDS_BYTES - LDSCTL_OFF) / 4; u += NWAVES * 64) ((LAS unsigned*)(F.lds + LDSCTL_OFF))[u] = 0u;
    __syncthreads();
    const int fused = args.fused;
    XcdBarrier bar; bar.bar = (unsigned*)(F.ws + WS_CTL) + CW_BAR; bar.x = 0; bar.st = nullptr;
    if (fused) bar = xcd_barrier_post((unsigned*)(F.ws + WS_CTL) + CW_BAR, F.MISC + 8);
    const int lo = args.ph_lo, hi = args.ph_hi;
#ifndef PHMASK
#define PHMASK 0xFFFFF
#endif
#define IN(k) (((PHMASK >> (k)) & 1) && lo <= (k) && (k) < hi)
#define PB() do { int t_ = threadIdx.x; asm volatile("" : "+v"(t_)); F.tid = t_; F.lane = t_ & 63; F.wave = __builtin_amdgcn_readfirstlane(t_ >> 6); } while (0)
#define SEAM() do { if (fused) xcd_barrier(bar); } while (0)
    PG8_LAS unsigned char* ring = (PG8_LAS unsigned char*)(F.lds + RING_OFF);

    for (int l = args.l_lo; l < args.l_hi; ++l) {
        const bool moe = (l & 1);
        const float* xin = (l == 0) ? args.in[0] : (const float*)F.out;

        if (IN(PH_CONV)) { PB(); if (l == 0) phase_mod(F, args); phase_conv(F, args, l); SEAM(); }

        if (IN(PH_NORM1)) { PB(); phase_norm<0>(F, args, l, xin); SEAM(); }

        if (IN(PH_GEMM_IN)) { PB();
            pg8::Gemm g{WSP(const bf16, WS_H), WSP(const bf16, WS_WIN), M, NP, D}; pg8::StaticOrder S; S.init(M, NP, F.G, (int)blockIdx.x);
            pg8::EpiPlain E{WSP(bf16, WS_P), NP, 1 << 20};
            pg8::gemm_phase<pg8::EpiPlain, pg8::StaticOrder, true, true>(ring, g, S, E);
            SEAM();
        }

        if (IN(PH_PREP)) { PB(); phase_gla_prep(F, args, l); phase_rwkv_prep(F, args, l); SEAM(); }

        if (IN(PH_GLASCAN)) { PB(); phase_gla_scan_ref(F, args); SEAM(); }

        if (IN(PH_RWSCAN)) { PB(); phase_rwkv_scan(F, args); SEAM(); }

        if (IN(PH_POST)) { PB(); phase_post(F, args, l); SEAM(); }

        if (IN(PH_GEMM_GLAO)) { PB();
            pg8::Gemm g{WSP(const bf16, WS_GO), WSP(const bf16, WS_GLAO), M, D, D}; pg8::StaticOrder S; S.init(M, D, F.G, (int)blockIdx.x);
            pg8::EpiGate E{WSP(bf16, WS_H), nullptr, WSP(const bf16, WS_P), D, NP, PC_GA};
            pg8::gemm_phase<pg8::EpiGate, pg8::StaticOrder, true, true>(ring, g, S, E);
            SEAM();
        }

        if (IN(PH_GEMM_RWO)) { PB();
            pg8::Gemm g{WSP(const bf16, WS_RY), WSP(const bf16, WS_RWO), M, D, 512}; pg8::StaticOrder S; S.init(M, D, F.G, (int)blockIdx.x);
            pg8::EpiGate E{WSP(bf16, WS_GO), WSP(const bf16, WS_H), WSP(const bf16, WS_P), D, NP, PC_GB};
            pg8::gemm_phase<pg8::EpiGate, pg8::StaticOrder, true, true>(ring, g, S, E);
            SEAM();
        }

        if (IN(PH_GEMM_OUT)) { PB();
            pg8::Gemm g{WSP(const bf16, WS_GO), WSP(const bf16, WS_WOUT), M, D, D}; pg8::StaticOrder S; S.init(M, D, F.G, (int)blockIdx.x);
            pg8::EpiResid E{xin, F.out, args.in[3] + (size_t)l * 6144 + 2048, WSP(const float, WS_MODP) + (size_t)l * 16 * 6144 + 2048, (size_t)4 * 16 * 6144};
            pg8::gemm_phase<pg8::EpiResid, pg8::StaticOrder, true, true>(ring, g, S, E);
            SEAM();
        }

        if (IN(PH_NORM2)) { PB(); if (moe) phase_norm<2>(F, args, l, F.out); else phase_norm<1>(F, args, l, F.out); SEAM(); }

        if (moe) {
            if (IN(PH_ROUTE2)) { PB(); phase_route2(F, args); SEAM(); }
            if (IN(PH_GEMM_UP)) { PB();
                const int nT = __builtin_amdgcn_readfirstlane(((const int*)(F.ws + WS_MOE + MO_NT))[0]);
                pg8::Gemm g{WSP(const bf16, WS_HA), WSP(const bf16, WS_MUP), nT * 256, 2 * MFF, D}; pg8::MoeOrder S; S.init_moe(nT, 2 * MFF / 256, F.G, (int)blockIdx.x, (const int*)(F.ws + WS_MOE + MO_TILE));
                pg8::EpiSwiglu E{WSP(bf16, WS_U), MFF, 2 * MFF / 256};
                pg8::gemm_phase<pg8::EpiSwiglu, pg8::MoeOrder, true, true>(ring, g, S, E);
                SEAM();
            }
            if (IN(PH_GEMM_DN)) { PB();
                const int nT = __builtin_amdgcn_readfirstlane(((const int*)(F.ws + WS_MOE + MO_NT))[0]);
                pg8::Gemm g{WSP(const bf16, WS_U), WSP(const bf16, WS_MDN), nT * 256, D, MFF}; pg8::MoeOrder S; S.init_moe(nT, D / 256, F.G, (int)blockIdx.x, (const int*)(F.ws + WS_MOE + MO_TILE));
                pg8::EpiPlain E{WSP(bf16, WS_HA), D, D / 256};
                pg8::gemm_phase<pg8::EpiPlain, pg8::MoeOrder, true, true>(ring, g, S, E);
                SEAM();
            }
            if (IN(PH_COMBINE)) { PB(); phase_combine(F, args, l); SEAM(); }
        } else {
            if (IN(PH_GEMM_UP)) { PB();
                pg8::Gemm g{WSP(const bf16, WS_H), WSP(const bf16, WS_FUP), M, 2 * FFN, D}; pg8::StaticOrder S; S.init(M, 2 * FFN, F.G, (int)blockIdx.x);
                pg8::EpiSwiglu E{WSP(bf16, WS_U), FFN, 1 << 20};
                pg8::gemm_phase<pg8::EpiSwiglu, pg8::StaticOrder, true, true>(ring, g, S, E);
                SEAM();
            }
            if (IN(PH_GEMM_DN)) { PB();
                pg8::Gemm g{WSP(const bf16, WS_U), WSP(const bf16, WS_FDN), M, D, FFN}; pg8::StaticOrder S; S.init(M, D, F.G, (int)blockIdx.x);
                pg8::EpiResid E{F.out, F.out, args.in[3] + (size_t)l * 6144 + 5120, WSP(const float, WS_MODP) + (size_t)l * 16 * 6144 + 5120, (size_t)4 * 16 * 6144};
                pg8::gemm_phase<pg8::EpiResid, pg8::StaticOrder, true, true>(ring, g, S, E);
                SEAM();
            }
        }
        if (l == DEPTH - 1 && IN(PH_FINAL)) { PB(); phase_final(F, args); }
    }
#undef IN
#undef SEAM
}

extern "C" void kernel_launch(void* const* d_in, const int* in_sizes, int n_in, void* d_out, int out_size, void* d_ws, size_t ws_size, hipStream_t stream) {
    static int grid = 0;
    if (grid == 0) {
        if (n_in != 32 || in_sizes[0] != M * D || out_size != M * D || ws_size < WS_END) { fprintf(stderr, "kernel_launch: unexpected shapes / workspace (n_in %d, ws %zu, need %zu); nothing launched\n", n_in, ws_size, (size_t)WS_END); grid = -1; return; }
        int dev = 0, cus = 0, per_cu = 0;
        if (hipGetDevice(&dev) != hipSuccess || hipDeviceGetAttribute(&cus, hipDeviceAttributeMultiprocessorCount, dev) != hipSuccess) { grid = -1; return; }
        if (hipFuncSetAttribute((const void*)mk_fwd, hipFuncAttributeMaxDynamicSharedMemorySize, LDS_BYTES) != hipSuccess) { fprintf(stderr, "kernel_launch: hipFuncSetAttribute failed\n"); grid = -1; return; }
        if (hipOccupancyMaxActiveBlocksPerMultiprocessor(&per_cu, (const void*)mk_fwd, NWAVES * 64, LDS_BYTES) != hipSuccess || per_cu < 1) fprintf(stderr, "kernel_launch: occupancy query reports %d\n", per_cu);
        (void)hipGetLastError();
        grid = 256;
        if (cus < 256) { fprintf(stderr, "kernel_launch: %d CUs < 256; nothing launched\n", cus); grid = -1; return; }
    }
    if (grid < 0) return;
    if (hipMemsetAsync((char*)d_ws + WS_CTL, 0, CTL_ZERO_BYTES, stream) != hipSuccess) return;
    Args a{};
    for (int i = 0; i < 32; ++i) a.in[i] = (const float*)d_in[i];
    a.out = (float*)d_out; a.ws = (unsigned char*)d_ws;
#if MK_FUSED
    a.l_lo = 0; a.l_hi = DEPTH; a.ph_lo = 0; a.ph_hi = PH_COUNT; a.fused = 1;
    hipLaunchKernelGGL(mk_fwd, dim3(grid), dim3(NWAVES * 64), LDS_BYTES, stream, a);
#else
    for (int l = 0; l < DEPTH; ++l)
        for (int ph = 0; ph < PH_COUNT; ++ph) {
            if (!(l & 1) && (ph == PH_ROUTE2 || ph == PH_COMBINE)) continue;
            if (ph == PH_FINAL && l != DEPTH - 1) continue;
            a.l_lo = l; a.l_hi = l + 1; a.ph_lo = ph; a.ph_hi = ph + 1; a.fused = 0;
            hipLaunchKernelGGL(mk_fwd, dim3(grid), dim3(NWAVES * 64), LDS_BYTES, stream, a);
        }
#endif
}
```

```cpp
#include <hip/hip_runtime.h>
#include <cstdio>
#include <cstdint>
#ifndef MK_FUSED
#define MK_FUSED 1
#endif
namespace pg8 {
#define PG8_LAS __attribute__((address_space(3)))
typedef unsigned short bf16_t;
typedef short bf16x8 __attribute__((ext_vector_type(8)));
typedef float f32x4 __attribute__((ext_vector_type(4)));
typedef unsigned u32x4 __attribute__((ext_vector_type(4)));
constexpr int BM = 256, BK = 64, HALF = 128, HTB = HALF * BK * 2  , STAGE_BYTES = 8 * HTB, NXCD = 8, WGM = 8;

__host__ __device__ __forceinline__ int lds_byte(int r, int c) { const int st = (r >> 4) * 2 + (c >> 5), rr = r & 15, cc = c & 31, ob = rr * 64 + cc * 2; return st * 1024 + (ob ^ (((ob >> 9) & 1) << 5)); }
__host__ __device__ __forceinline__ void stage_rc(int b, int& R, int& C) { const int st = b / 1024, sb = b % 1024, swz = sb ^ (((sb >> 9) & 1) << 5); R = (st >> 1) * 16 + swz / 64; C = (st & 1) * 32 + (swz % 64) / 2; }
__host__ __device__ __forceinline__ int perm32(int rho) { const int n = rho >> 4, i = rho & 15; return 8 * (i >> 2) + 4 * n + (i & 3); }

struct Unit { int pm, pn; };
struct Gemm { const bf16_t* A; const bf16_t* Bt; int M, N, K; };

struct StaticOrder {
    int nM, nN, nwg, G, c;
    __host__ __device__ void init(int M, int N, int G_, int c_) { nM = M / BM; nN = N / BM; nwg = nM * nN; G = G_; c = c_; }
    __host__ __device__ bool next(int i, Unit& u) const {
        const long L = (long)i * G + c; if (L >= nwg) return false;
        int wgid = (int)L; { const int q = nwg / NXCD, r = nwg % NXCD, xcd = wgid % NXCD, off = wgid / NXCD; wgid = (xcd < r ? xcd * (q + 1) : r * (q + 1) + (xcd - r) * q) + off; }
        const int nig = WGM * nN, gid = wgid / nig, fm = gid * WGM, gsz = (nM - fm) < WGM ? (nM - fm) : WGM;
        u.pm = fm + ((wgid % nig) % gsz); u.pn = (wgid % nig) / gsz; return true;
    }
    __device__ __forceinline__ void a_ready(const Unit&) const {}
    __device__ __forceinline__ void done(const Unit&) const {}
};
typedef float f32x2p __attribute__((ext_vector_type(2))); typedef __bf16 bf16x2p __attribute__((ext_vector_type(2)));
__device__ __forceinline__ unsigned cvt_pk_bf16(float lo, float hi) { const f32x2p v = {lo, hi}; const bf16x2p r = __builtin_convertvector(v, bf16x2p); return __builtin_bit_cast(unsigned, r); }
typedef float f32x2 __attribute__((ext_vector_type(2)));

__device__ __forceinline__ float bf_lo(unsigned w) { return __uint_as_float(w << 16); }
__device__ __forceinline__ float bf_hi(unsigned w) { return __uint_as_float(w & 0xffff0000u); }
__device__ __forceinline__ float fsigmoid(float x) { return __builtin_amdgcn_rcpf(1.0f + __builtin_amdgcn_exp2f(-1.4426950408889634f * x)); }
__device__ __forceinline__ float fsilu(float x) { return x * fsigmoid(x); }

struct EpiPlain {
    static constexpr bool PERM = true, AFTER_DRAIN = false;
    bf16_t* O; int ldc; int pn_mod;
    __device__ __forceinline__ void operator()(const f32x4 (&acc)[2][2][4][2], const Unit& u, int wr, int wc, int fr, int fq) const {
        const int row0 = u.pm * BM + wr * 64 + fr, col0 = (u.pn % pn_mod) * BM + wc * 32 + 8 * fq;
#pragma unroll
        for (int ai = 0; ai < 2; ++ai)
#pragma unroll
            for (int m = 0; m < 4; ++m) { bf16_t* rowp = O + (size_t)(row0 + ai * HALF + m * 16) * ldc + col0;
#pragma unroll
                for (int bj = 0; bj < 2; ++bj) { const f32x4 v0 = acc[ai][bj][m][0], v1 = acc[ai][bj][m][1];
                    u32x4 w; w.x = cvt_pk_bf16(v0[0], v0[1]); w.y = cvt_pk_bf16(v0[2], v0[3]); w.z = cvt_pk_bf16(v1[0], v1[1]); w.w = cvt_pk_bf16(v1[2], v1[3]);
                    *(u32x4*)(rowp + bj * HALF) = w; } }
    }
};
struct EpiPlainGate {
    static constexpr bool PERM = true, AFTER_DRAIN = false;
    bf16_t* O; int ldc; int gtile0; bf16_t* G; size_t gstride;
    __device__ __forceinline__ void operator()(const f32x4 (&acc)[2][2][4][2], const Unit& u, int wr, int wc, int fr, int fq) const {
        if (u.pn < gtile0) {
            const int row0 = u.pm * BM + wr * 64 + fr, col0 = u.pn * BM + wc * 32 + 8 * fq;
#pragma unroll
            for (int ai = 0; ai < 2; ++ai)
#pragma unroll
                for (int m = 0; m < 4; ++m) { bf16_t* rowp = O + (size_t)(row0 + ai * HALF + m * 16) * ldc + col0;
#pragma unroll
                    for (int bj = 0; bj < 2; ++bj) { const f32x4 v0 = acc[ai][bj][m][0], v1 = acc[ai][bj][m][1];
                        u32x4 w; w.x = cvt_pk_bf16(v0[0], v0[1]); w.y = cvt_pk_bf16(v0[2], v0[3]); w.z = cvt_pk_bf16(v1[0], v1[1]); w.w = cvt_pk_bf16(v1[2], v1[3]);
                        *(u32x4*)(rowp + bj * HALF) = w; } }
        } else {
            const int gi = u.pn - gtile0, wave = wr * 4 + wc, lane = fr + 16 * fq;
            bf16_t* gp = G + (size_t)(gi >> 2) * gstride + ((size_t)((u.pm * 4 + (gi & 3)) * 8 + wave) * 16) * 512 + lane * 8;
#pragma unroll
            for (int ai = 0; ai < 2; ++ai)
#pragma unroll
                for (int m = 0; m < 4; ++m)
#pragma unroll
                    for (int bj = 0; bj < 2; ++bj) { const f32x4 v0 = acc[ai][bj][m][0], v1 = acc[ai][bj][m][1];
                        u32x4 w; w.x = cvt_pk_bf16(fsigmoid(v0[0]), fsigmoid(v0[1])); w.y = cvt_pk_bf16(fsigmoid(v0[2]), fsigmoid(v0[3])); w.z = cvt_pk_bf16(fsigmoid(v1[0]), fsigmoid(v1[1])); w.w = cvt_pk_bf16(fsigmoid(v1[2]), fsigmoid(v1[3]));
                        *(u32x4*)(gp + ((ai * 4 + m) * 2 + bj) * 512) = w; }
        }
    }
};
struct EpiGate {
    static constexpr bool PERM = true, AFTER_DRAIN = false;
    bf16_t* O; bf16_t* TW; const bf16_t* TR; const bf16_t* gate; int ldc;
    __device__ __forceinline__ void operator()(const f32x4 (&acc)[2][2][4][2], const Unit& u, int wr, int wc, int fr, int fq) const {
        const int row0 = u.pm * BM + wr * 64 + fr, col0 = u.pn * BM + wc * 32 + 8 * fq, wave = wr * 4 + wc, lane = fr + 16 * fq;
        const size_t rbase = ((size_t)((u.pm * 4 + u.pn) * 8 + wave) * 16) * 512 + lane * 8;
#pragma unroll
        for (int ai = 0; ai < 2; ++ai)
#pragma unroll
            for (int m = 0; m < 4; ++m) { const size_t r = (size_t)(row0 + ai * HALF + m * 16);
#pragma unroll
                for (int bj = 0; bj < 2; ++bj) { const f32x4 v0 = acc[ai][bj][m][0], v1 = acc[ai][bj][m][1]; const size_t ro = rbase + ((ai * 4 + m) * 2 + bj) * 512;
                    const u32x4 g = *(const u32x4*)(gate + ro);
                    float o[8];
                    o[0] = bf_lo(g.x) * v0[0]; o[1] = bf_hi(g.x) * v0[1]; o[2] = bf_lo(g.y) * v0[2]; o[3] = bf_hi(g.y) * v0[3];
                    o[4] = bf_lo(g.z) * v1[0]; o[5] = bf_hi(g.z) * v1[1]; o[6] = bf_lo(g.w) * v1[2]; o[7] = bf_hi(g.w) * v1[3];
                    if (TR) { const u32x4 t = *(const u32x4*)(TR + ro);
                        o[0] += bf_lo(t.x); o[1] += bf_hi(t.x); o[2] += bf_lo(t.y); o[3] += bf_hi(t.y); o[4] += bf_lo(t.z); o[5] += bf_hi(t.z); o[6] += bf_lo(t.w); o[7] += bf_hi(t.w); }
                    u32x4 w; w.x = cvt_pk_bf16(o[0], o[1]); w.y = cvt_pk_bf16(o[2], o[3]); w.z = cvt_pk_bf16(o[4], o[5]); w.w = cvt_pk_bf16(o[6], o[7]);
                    if (TW) *(u32x4*)(TW + ro) = w; else *(u32x4*)(O + r * ldc + col0 + bj * HALF) = w; } }
    }
};
struct EpiResid {
    static constexpr bool PERM = false, AFTER_DRAIN = false;
    const float* Xin; float* Xout; const float* gbias; const float* gpart; size_t part_stride;
    __device__ __forceinline__ void operator()(const f32x4 (&acc)[2][2][4][2], const Unit& u, int wr, int wc, int fr, int fq) const {
        const int row0 = u.pm * BM + wr * 64 + fr, col0 = u.pn * BM + wc * 32 + 4 * fq; const int b = u.pm >> 3;
        f32x4 gv[2][2];
#pragma unroll
        for (int bj = 0; bj < 2; ++bj)
#pragma unroll
            for (int n = 0; n < 2; ++n) { const int c = col0 + bj * HALF + n * 16; f32x4 g = *(const f32x4*)(gbias + c);
#pragma unroll
                for (int q = 0; q < 4; ++q) g += *(const f32x4*)(gpart + q * part_stride + (size_t)b * 6144 + c);
                gv[bj][n] = g; }
#pragma unroll
        for (int ai = 0; ai < 2; ++ai)
#pragma unroll
            for (int m = 0; m < 4; ++m) { const size_t off = (size_t)(row0 + ai * HALF + m * 16) * 1024 + col0;
#pragma unroll
                for (int bj = 0; bj < 2; ++bj)
#pragma unroll
                    for (int n = 0; n < 2; ++n) { const f32x4 xi = *(const f32x4*)(Xin + off + bj * HALF + n * 16);
                        *(f32x4*)(Xout + off + bj * HALF + n * 16) = xi + gv[bj][n] * acc[ai][bj][m][n]; } }
    }
};
struct EpiDelta {
    static constexpr bool PERM = true, AFTER_DRAIN = false;
    bf16_t* Dl; const float* gbias; const float* gpart; size_t part_stride;
    __device__ __forceinline__ void operator()(const f32x4 (&acc)[2][2][4][2], const Unit& u, int wr, int wc, int fr, int fq) const {
        const int row0 = u.pm * BM + wr * 64 + fr, col0 = u.pn * BM + wc * 32 + 8 * fq; const int b = u.pm >> 3;
        f32x4 gv[2][2];
#pragma unroll
        for (int bj = 0; bj < 2; ++bj)
#pragma unroll
            for (int n = 0; n < 2; ++n) { const int c = col0 + bj * HALF + 4 * n; f32x4 g = *(const f32x4*)(gbias + c);
#pragma unroll
                for (int q = 0; q < 4; ++q) g += *(const f32x4*)(gpart + q * part_stride + (size_t)b * 6144 + c);
                gv[bj][n] = g; }
#pragma unroll
        for (int ai = 0; ai < 2; ++ai)
#pragma unroll
            for (int m = 0; m < 4; ++m) { bf16_t* rowp = Dl + (size_t)(row0 + ai * HALF + m * 16) * 1024 + col0;
#pragma unroll
                for (int bj = 0; bj < 2; ++bj) { const f32x4 v0 = acc[ai][bj][m][0] * gv[bj][0], v1 = acc[ai][bj][m][1] * gv[bj][1];
                    u32x4 w; w.x = cvt_pk_bf16(v0[0], v0[1]); w.y = cvt_pk_bf16(v0[2], v0[3]); w.z = cvt_pk_bf16(v1[0], v1[1]); w.w = cvt_pk_bf16(v1[2], v1[3]);
                    *(u32x4*)(rowp + bj * HALF) = w; } }
    }
};
struct EpiSwiglu {
    static constexpr bool PERM = true, AFTER_DRAIN = false;
    bf16_t* U; int ldc; int pn_mod;
    __device__ __forceinline__ void operator()(const f32x4 (&acc)[2][2][4][2], const Unit& u, int wr, int wc, int fr, int fq) const {
        const int row0 = u.pm * BM + wr * 64 + fr, col0 = (u.pn % pn_mod) * HALF + wc * 32 + 8 * fq;
#pragma unroll
        for (int ai = 0; ai < 2; ++ai)
#pragma unroll
            for (int m = 0; m < 4; ++m) { bf16_t* rowp = U + (size_t)(row0 + ai * HALF + m * 16) * ldc + col0;
                const f32x4 g0 = acc[ai][0][m][0], g1 = acc[ai][0][m][1], u0 = acc[ai][1][m][0], u1 = acc[ai][1][m][1];
                u32x4 w; w.x = cvt_pk_bf16(fsilu(g0[0]) * u0[0], fsilu(g0[1]) * u0[1]); w.y = cvt_pk_bf16(fsilu(g0[2]) * u0[2], fsilu(g0[3]) * u0[3]);
                w.z = cvt_pk_bf16(fsilu(g1[0]) * u1[0], fsilu(g1[1]) * u1[1]); w.w = cvt_pk_bf16(fsilu(g1[2]) * u1[2], fsilu(g1[3]) * u1[3]);
                *(u32x4*)rowp = w; }
    }
};
struct MoeOrder : StaticOrder {
    const int* tile_e; int nNloc;
    __device__ void init_moe(int nT, int nN_, int G_, int c_, const int* te) { nM = nT; nN = nN_; nwg = nM * nN; G = G_; c = c_; tile_e = te; nNloc = nN_; }
    __device__ bool next(int i, Unit& u) const {
        if (!StaticOrder::next(i, u)) return false;
        const int e = __builtin_amdgcn_readfirstlane(tile_e[u.pm]); u.pn += e * nNloc; return true;
    }
};
template <class Epi, class Sched, bool ALIGN_EPI = false, bool SP2 = false>
__device__ __forceinline__ void gemm_phase(PG8_LAS unsigned char* lds, const Gemm g, const Sched& S, const Epi& E) {
    int tid_ = threadIdx.x; asm volatile("" : "+v"(tid_));
    const int tid = tid_, wid = __builtin_amdgcn_readfirstlane(tid >> 6), lane = tid & 63, wr = wid >> 2, wc = wid & 3, fr = lane & 15, fq = lane >> 4;
    const int K = g.K, nt = K / BK;
    unsigned voffA[2], voffB[2];
#pragma unroll
    for (int i = 0; i < 2; ++i) { int R, C; stage_rc(tid * 16 + i * 8192, R, C); const int Rb = Epi::PERM ? ((R & ~31) + perm32(R & 31)) : R;
        voffA[i] = (unsigned)(R * K + C) * 2u; voffB[i] = (unsigned)(Rb * K + C) * 2u; }
    const size_t kstep = (size_t)(BK * 2);
    const size_t hstep = (size_t)HALF * K * 2;
    const size_t tstep = 2 * hstep;
    const unsigned ldsw = (unsigned)wid * 1024u;
    const int aoff = lds_byte(wr * 64 + fr, fq * 8), boff = lds_byte(wc * 32 + fr, fq * 8);
#define PG8_SA(b, h) (((b) * 2 + (h)) * HTB)
#define PG8_SB(b, h) ((4 + (b) * 2 + (h)) * HTB)
#define PG8_STAGE(bufoff, gbase, voff) do { _Pragma("unroll") for (int _i = 0; _i < 2; ++_i) \
        __builtin_amdgcn_global_load_lds((const unsigned*)((const char*)(gbase) + (voff)[_i]), (PG8_LAS unsigned*)(lds + (bufoff) + ldsw + _i * 8192), 16, 0, 0); } while (0)
#define PG8_LDA(dst, b, h) do { _Pragma("unroll") for (int m = 0; m < 4; ++m) _Pragma("unroll") for (int k = 0; k < 2; ++k) dst[m][k] = *(const PG8_LAS bf16x8*)(lds + PG8_SA(b, h) + aoff + m * 2048 + k * 1024); } while (0)
#define PG8_LDB(dst, b, h) do { _Pragma("unroll") for (int n = 0; n < 2; ++n) _Pragma("unroll") for (int k = 0; k < 2; ++k) dst[n][k] = *(const PG8_LAS bf16x8*)(lds + PG8_SB(b, h) + boff + n * 2048 + k * 1024); } while (0)
#define PG8_MMA(ai, bj, At, Bt) do { __builtin_amdgcn_s_setprio(1); _Pragma("unroll") for (int m = 0; m < 4; ++m) _Pragma("unroll") for (int n = 0; n < 2; ++n) _Pragma("unroll") for (int k = 0; k < 2; ++k) \
        acc[ai][bj][m][n] = __builtin_amdgcn_mfma_f32_16x16x32_bf16(Bt[n][k], At[m][k], acc[ai][bj][m][n], 0, 0, 0); __builtin_amdgcn_s_setprio(0); } while (0)
#define PG8_WAIT_V(n) asm volatile("s_waitcnt vmcnt(" #n ")" ::: "memory")
#define PG8_WAIT_L(n) asm volatile("s_waitcnt lgkmcnt(" #n ")" ::: "memory")
#define PG8_BAR __builtin_amdgcn_s_barrier()
#define PG8_SCHED __builtin_amdgcn_sched_barrier(0)
    Unit cur, nxt; int ui = 0;
    if (!S.next(0, cur)) return;
    f32x4 acc[2][2][4][2];
#pragma unroll
    for (int a = 0; a < 2; ++a)
#pragma unroll
        for (int b = 0; b < 2; ++b)
#pragma unroll
            for (int m = 0; m < 4; ++m)
#pragma unroll
                for (int n = 0; n < 2; ++n) acc[a][b][m][n] = (f32x4){0.f, 0.f, 0.f, 0.f};
    bf16x8 At[4][2], B0[2][2], B1[2][2];
    const char* cA = (const char*)g.A + (size_t)cur.pm * tstep; const char* cB = (const char*)g.Bt + (size_t)cur.pn * tstep;
    S.a_ready(cur);
    if constexpr (SP2) {
        PG8_STAGE(PG8_SB(0, 0), cB, voffB); PG8_STAGE(PG8_SB(0, 1), cB + hstep, voffB); PG8_STAGE(PG8_SA(0, 0), cA, voffA); PG8_STAGE(PG8_SA(0, 1), cA + hstep, voffA);
        if (wr == 1) PG8_BAR;
        PG8_WAIT_V(2); PG8_BAR;
        PG8_STAGE(PG8_SB(1, 0), cB + kstep, voffB); PG8_STAGE(PG8_SA(1, 0), cA + kstep, voffA); PG8_STAGE(PG8_SB(1, 1), cB + hstep + kstep, voffB);
        PG8_WAIT_V(6); PG8_BAR;
    } else {
        PG8_STAGE(PG8_SB(0, 0), cB, voffB); PG8_STAGE(PG8_SA(0, 0), cA, voffA); PG8_STAGE(PG8_SB(0, 1), cB + hstep, voffB); PG8_STAGE(PG8_SA(0, 1), cA + hstep, voffA);
        if (wr == 1) PG8_BAR;
        PG8_WAIT_V(4); PG8_BAR;
        PG8_STAGE(PG8_SB(1, 0), cB + kstep, voffB); PG8_STAGE(PG8_SA(1, 0), cA + kstep, voffA); PG8_STAGE(PG8_SB(1, 1), cB + hstep + kstep, voffB);
        PG8_WAIT_V(6); PG8_BAR;
    }
    for (;;) {
        const bool has_next = S.next(ui + 1, nxt);
        const char* nA = has_next ? (const char*)g.A + (size_t)nxt.pm * tstep : cA; const char* nB = has_next ? (const char*)g.Bt + (size_t)nxt.pn * tstep : cB;
        for (int t = 0; t < nt; t += 2) {
            const bool last = (t == nt - 2);
            const char* a1 = cA + (size_t)(t + 1) * kstep;
            const char* a2 = last ? nA : cA + (size_t)(t + 2) * kstep; const char* b2 = last ? nB : cB + (size_t)(t + 2) * kstep;
            const char* a3 = a2 + kstep; const char* b3 = b2 + kstep;
            if (last && has_next) S.a_ready(nxt);
            if constexpr (SP2) {
            PG8_LDB(B0, 0, 0); PG8_LDB(B1, 0, 1); PG8_SCHED; PG8_LDA(At, 0, 0); PG8_STAGE(PG8_SA(1, 1), a1 + hstep, voffA);
            PG8_WAIT_V(8); PG8_WAIT_L(0); PG8_BAR; PG8_MMA(0, 0, At, B0); PG8_MMA(0, 1, At, B1); PG8_BAR; PG8_SCHED;
            PG8_LDA(At, 0, 1); PG8_STAGE(PG8_SB(0, 0), b2, voffB); PG8_STAGE(PG8_SB(0, 1), b2 + hstep, voffB); PG8_STAGE(PG8_SA(0, 0), a2, voffA);
            PG8_WAIT_V(8); PG8_WAIT_L(0); PG8_BAR; PG8_MMA(1, 0, At, B0); PG8_MMA(1, 1, At, B1); PG8_BAR; PG8_SCHED;
            PG8_LDB(B0, 1, 0); PG8_LDB(B1, 1, 1); PG8_SCHED; PG8_LDA(At, 1, 0); PG8_STAGE(PG8_SA(0, 1), a2 + hstep, voffA);
            PG8_WAIT_V(8); PG8_WAIT_L(0); PG8_BAR; PG8_MMA(0, 0, At, B0); PG8_MMA(0, 1, At, B1); PG8_BAR; PG8_SCHED;
            PG8_LDA(At, 1, 1); PG8_STAGE(PG8_SB(1, 0), b3, voffB); PG8_STAGE(PG8_SB(1, 1), b3 + hstep, voffB); PG8_STAGE(PG8_SA(1, 0), a3, voffA);
            PG8_WAIT_V(8); PG8_WAIT_L(0); PG8_BAR; PG8_MMA(1, 0, At, B0); PG8_MMA(1, 1, At, B1); PG8_BAR; PG8_SCHED;
            } else {
            PG8_LDB(B0, 0, 0); PG8_SCHED; PG8_LDA(At, 0, 0); PG8_STAGE(PG8_SA(1, 1), a1 + hstep, voffA);
            PG8_WAIT_L(8); PG8_BAR; PG8_WAIT_L(0); PG8_MMA(0, 0, At, B0); PG8_BAR; PG8_SCHED;
            PG8_LDB(B1, 0, 1); PG8_STAGE(PG8_SB(0, 0), b2, voffB);
            PG8_BAR; PG8_WAIT_L(0); PG8_MMA(0, 1, At, B1); PG8_BAR;
            PG8_LDA(At, 0, 1); PG8_STAGE(PG8_SA(0, 0), a2, voffA);
            PG8_BAR; PG8_WAIT_L(0); PG8_MMA(1, 0, At, B0); PG8_BAR; PG8_SCHED;
            PG8_STAGE(PG8_SB(0, 1), b2 + hstep, voffB);
            PG8_WAIT_V(6); PG8_BAR; PG8_MMA(1, 1, At, B1); PG8_BAR;
            PG8_LDB(B0, 1, 0); PG8_SCHED; PG8_LDA(At, 1, 0); PG8_STAGE(PG8_SA(0, 1), a2 + hstep, voffA);
            PG8_WAIT_L(8); PG8_BAR; PG8_WAIT_L(0); PG8_MMA(0, 0, At, B0); PG8_BAR; PG8_SCHED;
            PG8_LDB(B1, 1, 1); PG8_STAGE(PG8_SB(1, 0), b3, voffB);
            PG8_BAR; PG8_WAIT_L(0); PG8_MMA(0, 1, At, B1); PG8_BAR;
            PG8_LDA(At, 1, 1); PG8_STAGE(PG8_SA(1, 0), a3, voffA);
            PG8_BAR; PG8_WAIT_L(0); PG8_MMA(1, 0, At, B0); PG8_BAR; PG8_SCHED;
            PG8_STAGE(PG8_SB(1, 1), b3 + hstep, voffB);
            PG8_WAIT_V(6); PG8_BAR; PG8_MMA(1, 1, At, B1); PG8_BAR;
            }
        }
        if constexpr (ALIGN_EPI) { if (wr == 0) PG8_BAR; }
        if constexpr (!Epi::AFTER_DRAIN) { E(acc, cur, wr, wc, fr, fq); S.done(cur); }
        if (!has_next) break;
#pragma unroll
        for (int a = 0; a < 2; ++a)
#pragma unroll
            for (int b = 0; b < 2; ++b)
#pragma unroll
                for (int m = 0; m < 4; ++m)
#pragma unroll
                    for (int n = 0; n < 2; ++n) acc[a][b][m][n] = (f32x4){0.f, 0.f, 0.f, 0.f};
        cur = nxt; cA = nA; cB = nB; ++ui;
        if constexpr (ALIGN_EPI) { if (wr == 1) PG8_BAR; }
    }
    PG8_WAIT_V(0);
    if constexpr (!ALIGN_EPI) { if (wr == 0) PG8_BAR; }
    PG8_BAR;
    if constexpr (Epi::AFTER_DRAIN) { E.fused(acc, cur, wr, wc, fr, fq, lds, wid, lane); S.done(cur); }
#undef PG8_SA
#undef PG8_SB
#undef PG8_STAGE
#undef PG8_LDA
#undef PG8_LDB
#undef PG8_MMA
#undef PG8_WAIT_V
#undef PG8_WAIT_L
#undef PG8_BAR
#undef PG8_SCHED
}
}

constexpr int NWAVES = 8;
constexpr int D = 1024, BATCH = 16, SEQ = 2048, M = BATCH * SEQ, DEPTH = 4;
constexpr int NIN = 6928, NPW = 7168, NP = 5120;
constexpr int PC_Q = 0, PC_K = 512, PC_V = 1024, PC_G = 2048, PC_R = 3072, PC_RK = 3584, PC_RV = 4096, PC_PA = 4608, PC_WD = 4640, PC_AD = 4704, PC_GD = 4768, PC_GA = 5120, PC_GB = 6144;
constexpr int FFN = 2816, MFF = 3584, NEXP = 8;
constexpr int MOE_ROWS = 2 * M + NEXP * 256;
constexpr float NORM_EPS = 1e-6f;

constexpr size_t MiB = 1u << 20;
constexpr size_t WS_CTL = 0, CTL_ZERO_BYTES = 64 * 1024;
constexpr size_t WS_W2T = 1 * MiB, WS_A2T = WS_W2T + 65536, WS_G2T = WS_A2T + 65536;
constexpr size_t WS_MODP = 2 * MiB;
constexpr size_t WS_WIN = 8 * MiB, WS_GLAO = 22 * MiB, WS_RWO = 24 * MiB, WS_WOUT = 25 * MiB, WS_WFF = 27 * MiB;
constexpr size_t WS_FUP = WS_WFF, WS_FDN = WS_WFF + 11 * MiB, WS_MUP = WS_WFF, WS_MDN = WS_WFF + 112 * MiB;
constexpr size_t WS_H = 196 * MiB;
constexpr size_t WS_P = 260 * MiB;
constexpr size_t WS_GATE = 580 * MiB;
constexpr size_t WS_GO = 708 * MiB;
constexpr size_t WS_MG = 772 * MiB;
constexpr size_t WS_RG = 900 * MiB, WS_RV = 936 * MiB, WS_RY = 968 * MiB;
constexpr size_t WS_BC = 1028 * MiB;
constexpr size_t WS_MOE = 1029 * MiB;
constexpr size_t WS_ATT = 1095 * MiB;
constexpr size_t WS_DL = 1111 * MiB;
constexpr size_t WS_END = 1112 * MiB;
constexpr size_t WS_P1T = 772 * MiB, WS_Q1T = 804 * MiB, WS_BKT = 836 * MiB, WS_WC = 932 * MiB;
constexpr size_t WS_VTR = 1031 * MiB, WS_ULT = 1063 * MiB;
constexpr size_t WS_QE = WS_H, WS_KDT = WS_H + 32 * MiB;
constexpr size_t WS_U = WS_P;
constexpr size_t WS_HA = 722 * MiB;
static_assert(WS_U + (size_t)MOE_ROWS * MFF * 2 <= WS_HA && WS_HA + (size_t)MOE_ROWS * D * 2 <= WS_BC, "moe overlay");
constexpr size_t MO_TOPI = 0, MO_TOPW = 256 * 1024, MO_POS = 512 * 1024, MO_CNT = 768 * 1024, MO_TILE = 800 * 1024, MO_NT = 832 * 1024;
constexpr int CW_BAR = 4096;

constexpr int RING_OFF = 0, RING_BYTES = 131072;
constexpr int LDSCTL_OFF = 146432, MISC_OFF = LDSCTL_OFF + 320;
constexpr int LDS_BYTES = 147456;
static_assert(MISC_OFF + 128 <= LDS_BYTES, "LDS map");

#define GAS __attribute__((address_space(1)))
#define LAS __attribute__((address_space(3)))
typedef unsigned short bf16;
typedef unsigned v4u __attribute__((ext_vector_type(4)));
typedef unsigned v2u __attribute__((ext_vector_type(2)));
typedef float f32x4 __attribute__((ext_vector_type(4)));
#define LDS_WAIT() asm volatile("s_waitcnt lgkmcnt(0)" ::: "memory")
#define VM_WAIT() asm volatile("s_waitcnt vmcnt(0)" ::: "memory")
__device__ __forceinline__ unsigned f2bf(float f) { unsigned u = __builtin_bit_cast(unsigned, f); return (u + 0x7fffu + ((u >> 16) & 1u)) >> 16; }
__device__ __forceinline__ unsigned pk2(float lo, float hi) { return f2bf(lo) | (f2bf(hi) << 16); }
__device__ __forceinline__ float bf2f(bf16 b) { return __uint_as_float(((unsigned)b) << 16); }
__device__ __forceinline__ float blo(unsigned w) { return __uint_as_float(w << 16); }
__device__ __forceinline__ float bhi(unsigned w) { return __uint_as_float(w & 0xffff0000u); }
__device__ __forceinline__ float fexp_(float x) { return __builtin_amdgcn_exp2f(1.4426950408889634f * x); }
__device__ __forceinline__ float sigmoidf_(float x) { return __builtin_amdgcn_rcpf(1.0f + fexp_(-x)); }
__device__ __forceinline__ float softplusf_(float x) { return fmaxf(x, 0.f) + 0.6931471805599453f * __builtin_amdgcn_logf(1.0f + fexp_(-fabsf(x))); }
__device__ __forceinline__ float tanhf_(float x) { return 1.0f - 2.0f * __builtin_amdgcn_rcpf(1.0f + fexp_(2.0f * x)); }
template <int CTRL, int RMASK> __device__ __forceinline__ float dppadd_(float x) { return x + __builtin_bit_cast(float, __builtin_amdgcn_update_dpp(0, __builtin_bit_cast(int, x), CTRL, RMASK, 0xf, false)); }
__device__ __forceinline__ float rowsum16(float x) { x = dppadd_<0x128, 0xf>(x); x = dppadd_<0x124, 0xf>(x); x = dppadd_<0x122, 0xf>(x); x = dppadd_<0x121, 0xf>(x); return x; }
__device__ __forceinline__ float sum8(float x) { x = dppadd_<0xB1, 0xf>(x); x = dppadd_<0x4E, 0xf>(x); x = dppadd_<0x141, 0xf>(x); return x; }
__device__ __forceinline__ float wave_sum(float v) {
    v = rowsum16(v);
    v = dppadd_<0x142, 0xa>(v);
    v = dppadd_<0x143, 0xc>(v);
    return __builtin_bit_cast(float, __builtin_amdgcn_readlane(__builtin_bit_cast(int, v), 63));
}

struct Args { const float* in[32]; float* out; unsigned char* ws; int l_lo, l_hi, ph_lo, ph_hi, fused, pad; };
#define XB_TMO      128
#define XB_XCNT(j)  (256  + 64 * (j))
#define XB_XSUB(j)  (1280 + 64 * (j))
#define XB_XGEN(j)  (2304 + 64 * (j))
#define XB_TOP      3328
#define XB_TOPGEN   3392
#define XCD_BAR_WORDS 3456
#define XB_SPIN_CAP (1u << 18)

__device__ __forceinline__ unsigned xb_ld(unsigned* p)              { return __hip_atomic_load(p, __ATOMIC_RELAXED, __HIP_MEMORY_SCOPE_AGENT); }
__device__ __forceinline__ unsigned xb_add(unsigned* p, unsigned v) { return __hip_atomic_fetch_add(p, v, __ATOMIC_RELAXED, __HIP_MEMORY_SCOPE_AGENT); }
__device__ __forceinline__ unsigned xb_xcc_id() { return (unsigned)__builtin_amdgcn_s_getreg((3 << 11) | 20) & 0xFu; }
#define XB_SPIN(cond, bar) do { unsigned _sp = 0; while (cond) { __builtin_amdgcn_s_sleep(1); \
    if ((++_sp & 255u) == 0u) { if (xb_ld(&(bar)[XB_TMO])) break; if (_sp > XB_SPIN_CAP) { atomicAdd(&(bar)[XB_TMO], 1u); break; } } } } while (0)

struct XcdBarrier {
    unsigned* bar; unsigned x;
    volatile LAS unsigned* st;
};

__device__ __forceinline__ XcdBarrier xcd_barrier_post(unsigned* bar, volatile LAS unsigned* st) {
    XcdBarrier b; b.bar = bar; b.x = xb_xcc_id(); b.st = st;
    if (threadIdx.x == 0) (void)xb_add(&bar[XB_XCNT(b.x)], 1u);
    return b;
}
__device__ __forceinline__ void xcd_barrier_complete(unsigned* bar, unsigned x, unsigned& nloc, unsigned& nx) {
    const unsigned G = gridDim.x * gridDim.y * gridDim.z;
    unsigned sum, cnt, mine, sp = 0u;
    for (;;) {
        sum = 0u; cnt = 0u; mine = 0u;
#pragma unroll
        for (unsigned j = 0; j < 16; ++j) { const unsigned c = xb_ld(&bar[XB_XCNT(j)]); sum += c; cnt += (c > 0u) ? 1u : 0u; mine = (j == x) ? c : mine; }
        if (sum == G) break;
        __builtin_amdgcn_s_sleep(1);
        if ((++sp & 255u) == 0u) { if (xb_ld(&bar[XB_TMO])) break; if (sp > XB_SPIN_CAP) { atomicAdd(&bar[XB_TMO], 1u); break; } }
    }
    nloc = mine > 0u ? mine : 1u; nx = cnt > 0u ? cnt : 1u;
}

__device__ __forceinline__ void xcd_barrier(const XcdBarrier& b) {
    asm volatile("s_waitcnt vmcnt(0)" ::: "memory");
    __syncthreads();
    if (threadIdx.x == 0) {
        unsigned* bar = b.bar;
        __builtin_amdgcn_s_waitcnt(0);
        unsigned nloc = b.st[0], nx = b.st[1];
        if (nloc == 0u) { xcd_barrier_complete(bar, b.x, nloc, nx); b.st[0] = nloc; b.st[1] = nx; }
        const unsigned old = xb_add(&bar[XB_XSUB(b.x)], 1u);
        const unsigned gen = old / nloc;
        if (old + 1u == (gen + 1u) * nloc) {
            __builtin_amdgcn_fence(__ATOMIC_RELEASE, "agent");
            asm volatile("s_waitcnt vmcnt(0)" ::: "memory");
            const unsigned og = xb_add(&bar[XB_TOP], 1u);
            const unsigned tg = og / nx;
            if (og + 1u == (tg + 1u) * nx) xb_add(&bar[XB_TOPGEN], 1u);
            else XB_SPIN(xb_ld(&bar[XB_TOPGEN]) == tg, bar);
            __builtin_amdgcn_fence(__ATOMIC_ACQUIRE, "agent");
            xb_add(&bar[XB_XGEN(b.x)], 1u);
            asm volatile("s_waitcnt vmcnt(0)" ::: "memory");
        } else {
            XB_SPIN(xb_ld(&bar[XB_XGEN(b.x)]) == gen, bar);
            __builtin_amdgcn_fence(__ATOMIC_ACQUIRE, "agent");
            asm volatile("s_waitcnt vmcnt(0)" ::: "memory");
        }
    }
    __syncthreads();
}

struct Frame {
    LAS unsigned char* lds;
    volatile LAS unsigned* MISC;
    int tid, lane, wave, vcu, G;
    float* out; unsigned char* ws;
};
#define WSP(T, off) ((T*)(F.ws + (off)))

__device__ __forceinline__ f32x4 mod4(const Frame& F, const Args& A, int l, int b, int j) {
    f32x4 v = *(const f32x4*)(A.in[3] + (size_t)l * 6144 + j);
    const float* mp = WSP(const float, WS_MODP);
#pragma unroll
    for (int q = 0; q < 4; ++q) v += *(const f32x4*)(mp + ((size_t)((q * 4 + l) * 16 + b)) * 6144 + j);
    return v;
}

__device__ __forceinline__ void phase_mod(Frame& F, const Args& A) {
    if (blockIdx.x < 192) {
        LAS float* sC = (LAS float*)F.lds;
        const int idx = blockIdx.x * 512 + F.tid, j = idx % 6144, ql = idx / 6144, l = ql & 3, q = ql >> 2;
        const float* c = A.in[1];
        for (int i = F.tid; i < 16 * 256; i += 512) { const int b = i >> 8, k = i & 255; const float cv = c[b * 1024 + q * 256 + k]; sC[i] = cv * sigmoidf_(cv); }
        __syncthreads();
        float acc[16];
#pragma unroll
        for (int b = 0; b < 16; ++b) acc[b] = 0.f;
        const float* wp = A.in[2] + ((size_t)l * 1024 + q * 256) * 6144 + j;
        for (int k0 = 0; k0 < 256; k0 += 16) { float wv[16];
#pragma unroll
            for (int kk = 0; kk < 16; ++kk) wv[kk] = wp[(size_t)(k0 + kk) * 6144];
#pragma unroll
            for (int kk = 0; kk < 16; ++kk)
#pragma unroll
                for (int b = 0; b < 16; ++b) acc[b] += sC[b * 256 + k0 + kk] * wv[kk]; }
        float* mp = WSP(float, WS_MODP);
#pragma unroll
        for (int b = 0; b < 16; ++b) mp[((size_t)((q * 4 + l) * 16 + b)) * 6144 + j] = acc[b];
    }
    __syncthreads();
}

__device__ __forceinline__ void transpose_item(const float* src, int ldsrc, int k0, int srccol, bf16* dst, int lddst, int drow0, LAS float* scr, int lane) {
    float tv[32];
#pragma unroll
    for (int i = 0; i < 32; ++i) { const int kk = 2 * i + (lane >> 5); tv[i] = srccol >= 0 ? src[(size_t)(k0 + kk) * ldsrc + srccol] : 0.f; }
#pragma unroll
    for (int i = 0; i < 32; ++i) { const int kk = 2 * i + (lane >> 5); scr[kk * 33 + (lane & 31)] = tv[i]; }
    LDS_WAIT(); asm volatile("" ::: "memory");
    const int c = lane & 7;
#pragma unroll
    for (int j = 0; j < 4; ++j) { const int n = (lane >> 3) + 8 * j; const LAS float* s = scr + (8 * c) * 33 + n;
        v4u o; o.x = pk2(s[0 * 33], s[1 * 33]); o.y = pk2(s[2 * 33], s[3 * 33]); o.z = pk2(s[4 * 33], s[5 * 33]); o.w = pk2(s[6 * 33], s[7 * 33]);
        *(v4u*)(dst + (size_t)(drow0 + n) * lddst + k0 + 8 * c) = o; }
    LDS_WAIT(); asm volatile("" ::: "memory");
}
__device__ __forceinline__ void transpose_item_lora(const float* src, int ldsrc, int k0, int srccol, bf16* dst, int fbase, int drow0, LAS float* scr, int lane) {
#pragma unroll 8
    for (int i = 0; i < 32; ++i) { const int kk = 2 * i + (lane >> 5); scr[kk * 33 + (lane & 31)] = src[(size_t)(k0 + kk) * ldsrc + srccol]; }
    LDS_WAIT(); asm volatile("" ::: "memory");
    const int c = lane & 7;
#pragma unroll
    for (int j = 0; j < 4; ++j) { const int n = (lane >> 3) + 8 * j; const LAS float* s = scr + (8 * c) * 33 + n;
        v4u o; o.x = pk2(s[0 * 33], s[1 * 33]); o.y = pk2(s[2 * 33], s[3 * 33]); o.z = pk2(s[4 * 33], s[5 * 33]); o.w = pk2(s[6 * 33], s[7 * 33]);
        const int ch = drow0 + n, k = k0 + 8 * c, f = fbase + (k >> 5), kq = (k & 31) >> 3;
        *(v4u*)(dst + ((size_t)((((ch >> 6) * 4 + ((ch >> 4) & 3)) * 8 + f) * 64) + (ch & 15) + 16 * kq) * 8) = o; }
    LDS_WAIT(); asm volatile("" ::: "memory");
}
__device__ __forceinline__ int win_srccol(int n) {
    if (n < 3072) return n;
    if (n < 3584) return 3088 + (n - 3072);
    if (n < 4096) return 3664 + (n - 3584);
    if (n < 4608) return 4176 + (n - 4096);
    if (n < 4624) return 3072 + (n - 4608);
    if (n < 4640) return -1;
    if (n < 4704) return 3600 + (n - 4640);
    if (n < 4768) return 4688 + (n - 4704);
    if (n < 4896) return 4752 + (n - 4768);
    if (n < 5120) return -1;
    if (n < 6144) return 4880 + (n - 5120);
    return 5904 + (n - 6144);
}
struct CItem { const float* sp; bf16* dp; int ldsrc, lddst, valid, lora, k0, drow0; };
__device__ __forceinline__ CItem conv_decode(Frame& F, const Args& A, int l, int it, int lane) {
    constexpr int I_LO = 16 + 16 + 32, I_IN = 16 * 224, I_GO = 16 * 32, I_RO = 8 * 32, I_WO = 16 * 32, I_FU = 16 * 176, I_MU = 8 * 16 * 224;
    const int l31 = lane & 31; const bool moe = (l & 1); const int li = l >> 1;
    CItem c; c.lora = -1; c.valid = 1; int r = it;
    const float* src; int srccol, kb, nb;
    if (r < I_LO) {
        if (r < 16) { src = A.in[13] + (size_t)l * 64 * 512; c.lora = 0; kb = 0; nb = r; }
        else if (r < 32) { src = A.in[15] + (size_t)l * 64 * 512; c.lora = 2; kb = 0; nb = r - 16; }
        else { src = A.in[16] + (size_t)l * 128 * 512; c.lora = 4; kb = (r - 32) >> 4; nb = (r - 32) & 15; }
        c.ldsrc = 512; srccol = nb * 32 + l31; c.dp = WSP(bf16, WS_W2T); c.lddst = 0; c.k0 = kb * 64; c.drow0 = nb * 32;
    } else if ((r -= I_LO) < I_IN) { kb = r / 224; nb = r % 224; src = A.in[6] + (size_t)l * 1024 * NIN; c.ldsrc = NIN; srccol = win_srccol(nb * 32 + l31); c.dp = WSP(bf16, WS_WIN); c.lddst = 1024; c.k0 = kb * 64; c.drow0 = nb * 32;
    } else if ((r -= I_IN) < I_GO) { kb = r / 32; nb = r % 32; src = A.in[10] + (size_t)l * 1024 * 1024; c.ldsrc = 1024; srccol = nb * 32 + l31; c.dp = WSP(bf16, WS_GLAO); c.lddst = 1024; c.k0 = kb * 64; c.drow0 = nb * 32;
    } else if ((r -= I_GO) < I_RO) { kb = r / 32; nb = r % 32; src = A.in[22] + (size_t)l * 512 * 1024; c.ldsrc = 1024; srccol = nb * 32 + l31; c.dp = WSP(bf16, WS_RWO); c.lddst = 512; c.k0 = kb * 64; c.drow0 = nb * 32;
    } else if ((r -= I_RO) < I_WO) { kb = r / 32; nb = r % 32; src = A.in[23] + (size_t)l * 1024 * 1024; c.ldsrc = 1024; srccol = nb * 32 + l31; c.dp = WSP(bf16, WS_WOUT); c.lddst = 1024; c.k0 = kb * 64; c.drow0 = nb * 32;
    } else { r -= I_WO;
        if (!moe) {
            if (r < I_FU) { kb = r / 176; nb = r % 176; const int n0 = nb * 32, pn = n0 >> 8, within = n0 & 255;
                src = (within < 128 ? A.in[24] : A.in[25]) + (size_t)li * 1024 * FFN; c.ldsrc = FFN; srccol = pn * 128 + (within & 127) + l31; c.dp = WSP(bf16, WS_FUP); c.lddst = 1024; c.k0 = kb * 64; c.drow0 = n0; }
            else { r -= I_FU; kb = r / 32; nb = r % 32; src = A.in[26] + (size_t)li * FFN * 1024; c.ldsrc = 1024; srccol = nb * 32 + l31; c.dp = WSP(bf16, WS_FDN); c.lddst = FFN; c.k0 = kb * 64; c.drow0 = nb * 32; }
        } else {
            if (r < I_MU) { const int e = r / (16 * 224), rr = r % (16 * 224); kb = rr / 224; nb = rr % 224; const int n0 = nb * 32, pn = n0 >> 8, within = n0 & 255;
                src = (within < 128 ? A.in[28] : A.in[29]) + ((size_t)(li * 8 + e)) * 1024 * MFF; c.ldsrc = MFF; srccol = pn * 128 + (within & 127) + l31; c.dp = WSP(bf16, WS_MUP) + (size_t)e * 7168 * 1024; c.lddst = 1024; c.k0 = kb * 64; c.drow0 = n0; }
            else { r -= I_MU; const int e = r / (56 * 32), rr = r % (56 * 32); kb = rr / 32; nb = rr % 32;
                src = A.in[30] + ((size_t)(li * 8 + e)) * MFF * 1024; c.ldsrc = 1024; srccol = nb * 32 + l31; c.dp = WSP(bf16, WS_MDN) + (size_t)e * 1024 * MFF; c.lddst = MFF; c.k0 = kb * 64; c.drow0 = nb * 32; }
        }
    }
    c.valid = srccol >= 0; c.sp = src + (size_t)c.k0 * c.ldsrc + (srccol >= 0 ? srccol : 0);
    return c;
}
__device__ __forceinline__ void conv_finish(const CItem& c, const float (&tv)[32], LAS float* scr, int lane) {
#pragma unroll
    for (int i = 0; i < 32; ++i) { const int kk = 2 * i + (lane >> 5); scr[kk * 33 + (lane & 31)] = tv[i]; }
    LDS_WAIT(); asm volatile("" ::: "memory");
    const int cc = lane & 7;
#pragma unroll
    for (int j = 0; j < 4; ++j) { const int n = (lane >> 3) + 8 * j; const LAS float* s = scr + (8 * cc) * 33 + n;
        v4u o; o.x = pk2(s[0 * 33], s[1 * 33]); o.y = pk2(s[2 * 33], s[3 * 33]); o.z = pk2(s[4 * 33], s[5 * 33]); o.w = pk2(s[6 * 33], s[7 * 33]);
        if (c.lora >= 0) { const int ch = c.drow0 + n, k = c.k0 + 8 * cc, f = c.lora + (k >> 5), kq = (k & 31) >> 3;
            *(v4u*)(c.dp + ((size_t)((((ch >> 6) * 4 + ((ch >> 4) & 3)) * 8 + f) * 64) + (ch & 15) + 16 * kq) * 8) = o; }
        else *(v4u*)(c.dp + (size_t)(c.drow0 + n) * c.lddst + c.k0 + 8 * cc) = o; }
    LDS_WAIT(); asm volatile("" ::: "memory");
}
__device__ __forceinline__ void phase_conv(Frame& F, const Args& A, int l) {
    LAS float* scr = (LAS float*)(F.lds + RING_OFF + F.wave * 16384);
    const int gw = F.vcu * NWAVES + F.wave, NGW = F.G * NWAVES, lane = F.lane;
    constexpr int I_LO = 16 + 16 + 32, I_IN = 16 * 224, I_GO = 16 * 32, I_RO = 8 * 32, I_WO = 16 * 32, I_FU = 16 * 176, I_FD = 44 * 32, I_MU = 8 * 16 * 224, I_MD = 8 * 56 * 32;
    const int nitems = I_LO + I_IN + I_GO + I_RO + I_WO + ((l & 1) ? (I_MU + I_MD) : (I_FU + I_FD));
    int it = gw; if (it >= nitems) return;
    CItem cur = conv_decode(F, A, l, it, lane); float tv[32];
#define CONV_LOAD(c_, t_) do { _Pragma("unroll") for (int i = 0; i < 32; ++i) { const int kk = 2 * i + (lane >> 5); (t_)[i] = (c_).valid ? (c_).sp[(size_t)kk * (c_).ldsrc] : 0.f; } } while (0)
    CONV_LOAD(cur, tv);
    for (;;) {
        const int nit = it + NGW; CItem nxt = cur; float tvn[32];
        if (nit < nitems) { nxt = conv_decode(F, A, l, nit, lane); CONV_LOAD(nxt, tvn); }
        conv_finish(cur, tv, scr, lane);
        if (nit >= nitems) break;
        cur = nxt; it = nit;
#pragma unroll
        for (int i = 0; i < 32; ++i) tv[i] = tvn[i];
    }
#undef CONV_LOAD
}

template <int WHICH>
__device__ __forceinline__ void phase_norm(Frame& F, const Args& A, int l, const float* xin, bool delta) {
    const int gw = F.vcu * NWAVES + F.wave, lane = F.lane, row0 = gw * 16, b = row0 >> 11;
    const float* gain = (WHICH == 0 ? A.in[4] : A.in[5]) + (size_t)l * 1024;
    const int jsh = (WHICH == 0 ? 0 : 3072), jsc = jsh + 1024;
    f32x4 g[4], sc[4], sh[4];
#pragma unroll
    for (int j = 0; j < 4; ++j) { const int c = 4 * lane + 256 * j; g[j] = *(const f32x4*)(gain + c); sc[j] = mod4(F, A, l, b, jsc + c) + 1.0f; sh[j] = mod4(F, A, l, b, jsh + c); g[j] = g[j] * sc[j]; }
    LAS float* sR = (LAS float*)F.lds;
    LAS int* sCnt = (LAS int*)(F.lds + 32768);
    if (WHICH == 2) {
        const float* rt = A.in[27] + (size_t)(l >> 1) * 1024 * 8;
        for (int i = F.tid; i < 8192; i += 512) sR[i] = rt[i];
        if (F.tid < 8) sCnt[F.tid] = 0;
        __syncthreads();
    }
    bf16* H = WSP(bf16, WS_H);
#pragma unroll 2
    for (int rr = 0; rr < 16; ++rr) {
        const int m = row0 + rr;
        f32x4 x[4]; float ss = 0.f;
#pragma unroll
        for (int j = 0; j < 4; ++j) { x[j] = *(const f32x4*)(xin + (size_t)m * 1024 + 4 * lane + 256 * j);
            if (delta) { const v2u dv = *(const v2u*)(H + (size_t)m * 1024 + 4 * lane + 256 * j); x[j].x += blo(dv.x); x[j].y += bhi(dv.x); x[j].z += blo(dv.y); x[j].w += bhi(dv.y);
                *(f32x4*)(F.out + (size_t)m * 1024 + 4 * lane + 256 * j) = x[j]; }
            ss += (x[j].x * x[j].x + x[j].y * x[j].y) + (x[j].z * x[j].z + x[j].w * x[j].w); }
        const float rs = __builtin_amdgcn_rsqf(wave_sum(ss) * (1.0f / 1024.0f) + NORM_EPS);
#pragma unroll
        for (int j = 0; j < 4; ++j) { x[j] = (x[j] * rs) * g[j] + sh[j];
            v2u o; o.x = pk2(x[j].x, x[j].y); o.y = pk2(x[j].z, x[j].w);
            *(v2u*)(H + (size_t)m * 1024 + 4 * lane + 256 * j) = o; }
        if (WHICH == 2) {
            float lg[8];
#pragma unroll
            for (int e = 0; e < 8; ++e) lg[e] = 0.f;
#pragma unroll
            for (int j = 0; j < 4; ++j)
#pragma unroll
                for (int i = 0; i < 4; ++i) { const int c = 4 * lane + 256 * j + i; const f32x4 r0 = *(const LAS f32x4*)(sR + c * 8), r1 = *(const LAS f32x4*)(sR + c * 8 + 4); const float xv = x[j][i];
                    lg[0] += xv * r0.x; lg[1] += xv * r0.y; lg[2] += xv * r0.z; lg[3] += xv * r0.w; lg[4] += xv * r1.x; lg[5] += xv * r1.y; lg[6] += xv * r1.z; lg[7] += xv * r1.w; }
#pragma unroll
            for (int e = 0; e < 8; ++e) lg[e] = wave_sum(lg[e]);
            if (lane == 0) {
                int i1 = 0; float v1 = lg[0];
#pragma unroll
                for (int e = 1; e < 8; ++e) if (lg[e] > v1) { v1 = lg[e]; i1 = e; }
                int i2 = (i1 + 1) & 7; float v2 = lg[i2];
#pragma unroll
                for (int e = 0; e < 8; ++e) if (e != i1 && (lg[e] > v2 || (lg[e] == v2 && e < i2))) { v2 = lg[e]; i2 = e; }
                const float w2 = 1.0f / (1.0f + fexp_(v1 - v2)), w1 = 1.0f - w2;
                int* topi = (int*)(F.ws + WS_MOE + MO_TOPI); float* topw = (float*)(F.ws + WS_MOE + MO_TOPW);
                topi[2 * m] = i1; topi[2 * m + 1] = i2; topw[2 * m] = w1; topw[2 * m + 1] = w2;
                atomicAdd((int*)&sCnt[i1], 1); atomicAdd((int*)&sCnt[i2], 1);
            }
        }
    }
    if (WHICH == 2) {
        __syncthreads();
        if (F.tid < 8) ((int*)(F.ws + WS_MOE + MO_CNT))[F.vcu * 8 + F.tid] = sCnt[F.tid];
        __syncthreads();
    }
}

__device__ __forceinline__ void phase_route2(Frame& F, const Args& A) {
    LAS int* sI = (LAS int*)F.lds;
    const int* cnt = (const int*)(F.ws + WS_MOE + MO_CNT);
    const int* topi = (const int*)(F.ws + WS_MOE + MO_TOPI);
    int* pos = (int*)(F.ws + WS_MOE + MO_POS);
    const int wgi = F.vcu, m0 = wgi * 128, lane = F.lane, e = F.wave;
    LAS int* sT = sI + 512;
    if (F.tid < 256) sT[F.tid] = topi[2 * m0 + F.tid];
    { int tot = 0, pre = 0;
#pragma unroll
      for (int j = 0; j < 4; ++j) { const int w = 4 * lane + j; const int c = cnt[w * 8 + e]; tot += c; pre += (w < wgi) ? c : 0; }
#pragma unroll
      for (int o = 1; o < 64; o <<= 1) { tot += __shfl_xor(tot, o); pre += __shfl_xor(pre, o); }
      if (lane == 0) { sI[e] = tot; sI[8 + e] = pre; } }
    __syncthreads();
    if (F.tid == 0) { int base = 0; for (int k = 0; k < 8; ++k) { sI[16 + k] = base; base += ((sI[k] + 255) >> 8) << 8; } sI[24] = base; }
    __syncthreads();
    { int run = sI[16 + e] + sI[8 + e];
#pragma unroll
      for (int k = 0; k < 4; ++k) { const bool hit = sT[k * 64 + lane] == e; const unsigned long long mk = __ballot(hit);
          const int rank = __popcll(mk & ((1ull << lane) - 1ull));
          if (hit) sI[32 + k * 64 + lane] = run + rank; run += __popcll(mk); } }
    __syncthreads();
    if (F.tid < 256) pos[2 * m0 + F.tid] = sI[32 + F.tid];
    if (wgi == 0 && F.tid >= 64 && F.tid < 64 + 264) {
        const int t = F.tid - 64; int ee = 0;
#pragma unroll
        for (int k = 1; k < 8; ++k) if (t * 256 >= sI[16 + k]) ee = k;
        ((int*)(F.ws + WS_MOE + MO_TILE))[t] = ee;
        if (t == 0) ((int*)(F.ws + WS_MOE + MO_NT))[0] = sI[24] >> 8;
    }
    const bf16* H = WSP(const bf16, WS_H); bf16* HA = WSP(bf16, WS_HA);
#pragma unroll
    for (int p0 = 0; p0 < 32; p0 += 16) { v4u ra[16], rb[16];
#pragma unroll
        for (int q = 0; q < 16; ++q) { const int p = F.wave * 32 + p0 + q, m = m0 + (p >> 1); ra[q] = *(const v4u*)(H + (size_t)m * 1024 + lane * 16); rb[q] = *(const v4u*)(H + (size_t)m * 1024 + lane * 16 + 8); }
#pragma unroll
        for (int q = 0; q < 16; ++q) { const int slot = sI[32 + F.wave * 32 + p0 + q]; *(v4u*)(HA + (size_t)slot * 1024 + lane * 16) = ra[q]; *(v4u*)(HA + (size_t)slot * 1024 + lane * 16 + 8) = rb[q]; } }
    if (wgi < 8) { const int lo = sI[16 + wgi] + sI[wgi], hi = sI[16 + wgi + 1];
        const v4u z = {0u, 0u, 0u, 0u};
        for (int r = lo + F.wave; r < hi; r += NWAVES) { *(v4u*)(HA + (size_t)r * 1024 + lane * 16) = z; *(v4u*)(HA + (size_t)r * 1024 + lane * 16 + 8) = z; } }
    __syncthreads();
}

__device__ __forceinline__ void phase_combine(Frame& F, const Args& A, int l, bool dry) {
    const int gw = F.vcu * NWAVES + F.wave, lane = F.lane, row0 = gw * 16, b = row0 >> 11;
    const bool last = (l == DEPTH - 1);
    f32x4 g2[4], ng[4], nsh[4];
#pragma unroll
    for (int j = 0; j < 4; ++j) { const int c = 4 * lane + 256 * j; g2[j] = mod4(F, A, l, b, 5120 + c);
        if (last) { ng[j] = *(const f32x4*)(A.in[31] + c); nsh[j] = (f32x4){0.f, 0.f, 0.f, 0.f}; }
        else { ng[j] = *(const f32x4*)(A.in[4] + (size_t)(l + 1) * 1024 + c) * (mod4(F, A, l + 1, b, 1024 + c) + 1.0f); nsh[j] = mod4(F, A, l + 1, b, c); } }
    const int* pos = (const int*)(F.ws + WS_MOE + MO_POS); const float* topw = (const float*)(F.ws + WS_MOE + MO_TOPW);
    const bf16* YP = WSP(const bf16, WS_HA); bf16* H = dry ? (bf16*)(F.ws + 1031 * MiB) : WSP(bf16, WS_H); float* xo = dry ? (float*)(F.ws + 27 * MiB) : F.out;
    const int myp = pos[2 * row0 + (lane & 31)]; const float myw = topw[2 * row0 + (lane & 31)];
#pragma unroll 4
    for (int rr = 0; rr < 16; ++rr) { const int m = row0 + rr; const int p1 = __shfl(myp, 2 * rr), p2 = __shfl(myp, 2 * rr + 1); const float w1 = __shfl(myw, 2 * rr), w2 = __shfl(myw, 2 * rr + 1);
        f32x4 x[4]; float ss = 0.f;
#pragma unroll
        for (int j = 0; j < 4; ++j) { const int c = 4 * lane + 256 * j; const v2u a = *(const v2u*)(YP + (size_t)p1 * 1024 + c), bb = *(const v2u*)(YP + (size_t)p2 * 1024 + c);
            f32x4 y; y.x = w1 * blo(a.x) + w2 * blo(bb.x); y.y = w1 * bhi(a.x) + w2 * bhi(bb.x); y.z = w1 * blo(a.y) + w2 * blo(bb.y); y.w = w1 * bhi(a.y) + w2 * bhi(bb.y);
            x[j] = *(const f32x4*)(F.out + (size_t)m * 1024 + c) + g2[j] * y; ss += (x[j].x * x[j].x + x[j].y * x[j].y) + (x[j].z * x[j].z + x[j].w * x[j].w); }
        const float rs = __builtin_amdgcn_rsqf(wave_sum(ss) * (1.0f / 1024.0f) + NORM_EPS);
#pragma unroll
        for (int j = 0; j < 4; ++j) { const int c = 4 * lane + 256 * j; float* xp = xo + (size_t)m * 1024 + c;
            const f32x4 hn = (x[j] * rs) * ng[j] + nsh[j];
            if (last) *(f32x4*)xp = hn;
            else { *(f32x4*)xp = x[j]; v2u o; o.x = pk2(hn.x, hn.y); o.y = pk2(hn.z, hn.w); *(v2u*)(H + (size_t)m * 1024 + c) = o; } } }
}

__device__ __forceinline__ void phase_final(Frame& F, const Args& A) {
    const int gw = F.vcu * NWAVES + F.wave, lane = F.lane, row0 = gw * 16;
    f32x4 g[4];
#pragma unroll
    for (int j = 0; j < 4; ++j) g[j] = *(const f32x4*)(A.in[31] + 4 * lane + 256 * j);
    for (int rr = 0; rr < 16; ++rr) { const int m = row0 + rr; f32x4 x[4]; float ss = 0.f;
#pragma unroll
        for (int j = 0; j < 4; ++j) { x[j] = *(const f32x4*)(F.out + (size_t)m * 1024 + 4 * lane + 256 * j); ss += (x[j].x * x[j].x + x[j].y * x[j].y) + (x[j].z * x[j].z + x[j].w * x[j].w); }
        const float rs = __builtin_amdgcn_rsqf(wave_sum(ss) * (1.0f / 1024.0f) + NORM_EPS);
#pragma unroll
        for (int j = 0; j < 4; ++j) *(f32x4*)(F.out + (size_t)m * 1024 + 4 * lane + 256 * j) = (x[j] * rs) * g[j]; }
}

__device__ __forceinline__ void phase_post(Frame& F, const Args& A, int l, bool dry) {
    const int gw = F.vcu * NWAVES + F.wave, lane = F.lane, row0 = gw * 16;
    const bf16* P = WSP(const bf16, WS_P); bf16* GO = WSP(bf16, WS_GO); bf16* RY = WSP(bf16, WS_RY);
    bf16* GOo = dry ? (bf16*)(F.ws + 772 * MiB) : GO; bf16* RYo = dry ? (bf16*)(F.ws + 836 * MiB) : RY;
    const bf16* RV = WSP(const bf16, WS_RV); const bf16* RG = WSP(const bf16, WS_RG); const float* BC = WSP(const float, WS_BC);
    float ng[16];
    { const float* p = A.in[9] + (size_t)l * 1024 + 16 * lane;
#pragma unroll
      for (int i = 0; i < 4; ++i) { const f32x4 v = *(const f32x4*)(p + 4 * i); ng[4 * i] = v.x; ng[4 * i + 1] = v.y; ng[4 * i + 2] = v.z; ng[4 * i + 3] = v.w; } }
    float lg[8], lb[8];
    { const float* p = A.in[20] + (size_t)l * 512 + 8 * lane; const float* q = A.in[21] + (size_t)l * 512 + 8 * lane;
#pragma unroll
      for (int i = 0; i < 8; ++i) { lg[i] = p[i]; lb[i] = q[i]; } }
#pragma unroll 2
    for (int rr = 0; rr < 16; ++rr) { const size_t m = (size_t)(row0 + rr);
        { bf16* gp = GO + m * 1024 + 16 * lane; const bf16* pg = P + m * NP + PC_G + 16 * lane;
          const v4u a = *(const v4u*)gp, b = *(const v4u*)(gp + 8), ga = *(const v4u*)pg, gb = *(const v4u*)(pg + 8);
          float o[16] = {blo(a.x), bhi(a.x), blo(a.y), bhi(a.y), blo(a.z), bhi(a.z), blo(a.w), bhi(a.w), blo(b.x), bhi(b.x), blo(b.y), bhi(b.y), blo(b.z), bhi(b.z), blo(b.w), bhi(b.w)};
          float g[16] = {blo(ga.x), bhi(ga.x), blo(ga.y), bhi(ga.y), blo(ga.z), bhi(ga.z), blo(ga.w), bhi(ga.w), blo(gb.x), bhi(gb.x), blo(gb.y), bhi(gb.y), blo(gb.z), bhi(gb.z), blo(gb.w), bhi(gb.w)};
          float ss = 0.f;
#pragma unroll
          for (int i = 0; i < 16; ++i) ss += o[i] * o[i];
          ss = rowsum16(ss);
          const float rs = __builtin_amdgcn_rsqf(ss * (1.0f / 256.0f) + 1e-5f);
#pragma unroll
          for (int i = 0; i < 16; ++i) o[i] = o[i] * rs * ng[i] * (g[i] * sigmoidf_(g[i]));
          v4u w0, w1; w0.x = pk2(o[0], o[1]); w0.y = pk2(o[2], o[3]); w0.z = pk2(o[4], o[5]); w0.w = pk2(o[6], o[7]); w1.x = pk2(o[8], o[9]); w1.y = pk2(o[10], o[11]); w1.z = pk2(o[12], o[13]); w1.w = pk2(o[14], o[15]);
          bf16* gq = GOo + m * 1024 + 16 * lane; *(v4u*)gq = w0; *(v4u*)(gq + 8) = w1; }
        { bf16* yp = RY + m * 512 + 8 * lane; const v4u a = *(const v4u*)yp, vv = *(const v4u*)(RV + m * 512 + 8 * lane), gg = *(const v4u*)(RG + m * 512 + 8 * lane);
          float y[8] = {blo(a.x), bhi(a.x), blo(a.y), bhi(a.y), blo(a.z), bhi(a.z), blo(a.w), bhi(a.w)};
          float v[8] = {blo(vv.x), bhi(vv.x), blo(vv.y), bhi(vv.y), blo(vv.z), bhi(vv.z), blo(vv.w), bhi(vv.w)};
          float g[8] = {blo(gg.x), bhi(gg.x), blo(gg.y), bhi(gg.y), blo(gg.z), bhi(gg.z), blo(gg.w), bhi(gg.w)};
          float s = 0.f;
#pragma unroll
          for (int i = 0; i < 8; ++i) s += y[i];
          s = sum8(s);
          const float mean = s * (1.0f / 64.0f); float q = 0.f;
#pragma unroll
          for (int i = 0; i < 8; ++i) { y[i] -= mean; q += y[i] * y[i]; }
          q = sum8(q);
          const float rs = __builtin_amdgcn_rsqf(q * (1.0f / 64.0f) + 64e-5f);
          const float bc = BC[m * 8 + (lane >> 3)];
#pragma unroll
          for (int i = 0; i < 8; ++i) y[i] = (y[i] * rs * lg[i] + lb[i] + bc * v[i]) * g[i];
          v4u w; w.x = pk2(y[0], y[1]); w.y = pk2(y[2], y[3]); w.z = pk2(y[4], y[5]); w.w = pk2(y[6], y[7]);
          *(v4u*)(RYo + m * 512 + 8 * lane) = w; }
    }
}

typedef short bf16x8v __attribute__((ext_vector_type(8)));
__device__ __forceinline__ void phase_gla_d1(Frame& F, const Args& A, int l, int wsel, int nwg) {
    const int tid = F.tid, lane = F.lane, w = F.wave, d = tid & 127, rq = tid >> 7;
    LAS float* sPA = (LAS float*)F.lds;
    LAS float* sTot = sPA + 1024;
    LAS bf16* sQE = (LAS bf16*)(F.lds + 8192);
    LAS bf16* sKE = (LAS bf16*)(F.lds + 8192 + 17408);
    LAS bf16* sV = (LAS bf16*)(F.lds + 8192 + 2 * 17408);
    const bf16* P = WSP(const bf16, WS_P);
    bf16* QE = WSP(bf16, WS_QE); bf16* KDT = WSP(bf16, WS_KDT); bf16* ATT = WSP(bf16, WS_ATT); float* DL = WSP(float, WS_DL);
    const float* au = A.in[7] + (size_t)l * 16 * 512; const float* ab = A.in[8] + (size_t)l * 512;
    const float scale = 0.08838834764831845f;
    const int h = wsel & 3, cg = wsel >> 2, npw = 2048 / nwg;
    float auv[16];
#pragma unroll
    for (int r = 0; r < 16; ++r) auv[r] = au[r * 512 + h * 128 + d];
    const float abv = ab[h * 128 + d];
    unsigned g_pa; v4u g_q[2], g_k[2];
#define D1_ISSUE(bn_) do { const size_t m0_ = (size_t)((bn_) >> 5) * 2048 + (size_t)((bn_) & 31) * 64; \
        g_pa = *(const unsigned*)(P + (m0_ + (tid >> 3)) * NP + PC_PA + (tid & 7) * 2); \
        _Pragma("unroll") for (int i = 0; i < 2; ++i) { const int idx = tid + 512 * i; g_q[i] = *(const v4u*)(P + (m0_ + (idx >> 4)) * NP + PC_Q + h * 128 + (idx & 15) * 8); \
                                                          g_k[i] = *(const v4u*)(P + (m0_ + (idx >> 4)) * NP + PC_K + h * 128 + (idx & 15) * 8); } } while (0)
    D1_ISSUE(cg * npw);
    for (int ui = 0; ui < npw; ++ui) {
        const int bn = cg * npw + ui, u = bn * 4 + h;
        sPA[tid * 2] = blo(g_pa); sPA[tid * 2 + 1] = bhi(g_pa);
#pragma unroll
        for (int i = 0; i < 2; ++i) { const int idx = tid + 512 * i; *(LAS v4u*)(sQE + (idx >> 4) * 136 + (idx & 15) * 8) = g_q[i]; *(LAS v4u*)(sKE + (idx >> 4) * 136 + (idx & 15) * 8) = g_k[i]; }
        __syncthreads();
        if (ui + 1 < npw) D1_ISSUE(bn + 1);
        float c[16]; float run = 0.f;
#pragma unroll
        for (int rr = 0; rr < 16; ++rr) { const int row = rq * 16 + rr; float z = abv;
#pragma unroll
            for (int r4 = 0; r4 < 4; ++r4) { const f32x4 pv = *(const LAS f32x4*)(sPA + row * 16 + r4 * 4); z += pv.x * auv[4 * r4] + pv.y * auv[4 * r4 + 1] + pv.z * auv[4 * r4 + 2] + pv.w * auv[4 * r4 + 3]; }
            run += -softplusf_(-z) * 0.0625f; c[rr] = run; }
        sTot[rq * 128 + d] = run;
        __syncthreads();
        float offs = 0.f, btot = 0.f;
#pragma unroll
        for (int q = 0; q < 4; ++q) { const float t = sTot[q * 128 + d]; btot += t; offs += (q < rq) ? t : 0.f; }
        unsigned kdp[8];
#pragma unroll
        for (int rr = 0; rr < 16; ++rr) { const int row = rq * 16 + rr; const float bc = offs + c[rr];
            const float q = bf2f(sQE[row * 136 + d]) * scale, k = bf2f(sKE[row * 136 + d]);
            const unsigned qe = f2bf(q * fexp_(bc)), ke = f2bf(k * fexp_(-bc)), kd = f2bf(k * fexp_(btot - bc));
            sQE[row * 136 + d] = (bf16)qe; sKE[row * 136 + d] = (bf16)ke;
            if (rr & 1) kdp[rr >> 1] |= kd << 16; else kdp[rr >> 1] = kd; }
        { bf16* kp = KDT + (((size_t)u * 16 + ((d >> 6) * 4 + ((d >> 4) & 3)) * 2 + (rq >> 1)) * 64 + (d & 15) + 16 * ((rq & 1) * 2)) * 8; v4u a, b; a.x = kdp[0]; a.y = kdp[1]; a.z = kdp[2]; a.w = kdp[3]; b.x = kdp[4]; b.y = kdp[5]; b.z = kdp[6]; b.w = kdp[7];
          *(v4u*)kp = a; *(v4u*)(kp + 128) = b; }
        if (rq == 0) DL[(size_t)u * 128 + d] = fexp_(btot);
        __syncthreads();
#pragma unroll
        for (int i = 0; i < 2; ++i) { const int pi = tid + 512 * i, blk = pi >> 6, ln = pi & 63, row = (blk >> 2) * 16 + (ln & 15), d0 = ((blk >> 1) & 1) * 64 + (blk & 1) * 32 + (ln >> 4) * 4;
            const v2u lo = *(const LAS v2u*)(sQE + row * 136 + d0), hi = *(const LAS v2u*)(sQE + row * 136 + d0 + 16);
            v4u o; o.x = lo.x; o.y = lo.y; o.z = hi.x; o.w = hi.y; *(v4u*)(QE + (((size_t)u * 16 + blk) * 64 + ln) * 8) = o; }
        { const int jt = w & 3, l15 = lane & 15, kq = lane >> 4;
#pragma unroll
          for (int ii = 0; ii < 2; ++ii) { const int it = 2 * (w >> 2) + ii; pg8::f32x4 acc = {0.f, 0.f, 0.f, 0.f};
            if (it >= jt) {
#pragma unroll
                for (int ks = 0; ks < 4; ++ks) { const bf16x8v a = *(const LAS bf16x8v*)(sKE + (jt * 16 + l15) * 136 + ks * 32 + kq * 8), b = *(const LAS bf16x8v*)(sQE + (it * 16 + l15) * 136 + ks * 32 + kq * 8);
                    acc = __builtin_amdgcn_mfma_f32_16x16x32_bf16(a, b, acc, 0, 0, 0); } }
            const int i = it * 16 + l15, j0 = jt * 16 + kq * 4;
            v2u o; o.x = pk2(i >= j0 ? acc[0] : 0.f, i >= j0 + 1 ? acc[1] : 0.f); o.y = pk2(i >= j0 + 2 ? acc[2] : 0.f, i >= j0 + 3 ? acc[3] : 0.f);
            *(v2u*)(ATT + (((size_t)u * 8 + it * 2 + (jt >> 1)) * 64 + l15 + 16 * ((jt & 1) * 2 + (kq >> 1))) * 8 + (kq & 1) * 4) = o; } }
        __syncthreads();
    }
#undef D1_ISSUE
}

typedef float f32x2g __attribute__((ext_vector_type(2))); typedef __bf16 bf16x2g __attribute__((ext_vector_type(2)));
__device__ __forceinline__ unsigned cvtpk(float lo, float hi) { const f32x2g v = {lo, hi}; const bf16x2g r = __builtin_convertvector(v, bf16x2g); return __builtin_bit_cast(unsigned, r); }
__device__ __forceinline__ bf16x8v as_bf8(v4u x) { return __builtin_bit_cast(bf16x8v, x); }
__device__ __forceinline__ void phase_gla_d2(Frame& F, const Args& A) {
    const int wgi = F.vcu, b = wgi >> 4, h = (wgi >> 2) & 3, vq = wgi & 3, w = F.wave, lane = F.lane;
    const int vb = w & 3, half = w >> 2, l15 = lane & 15, kq = lane >> 4;
    LAS pg8::f32x4* sO = (LAS pg8::f32x4*)F.lds;
    LAS unsigned char* sVc = F.lds + 32768;
    LAS unsigned char* ring = F.lds + 49152;
    const bf16* P = WSP(const bf16, WS_P);
    const int vst = F.tid >> 3, vsc = F.tid & 7;
    const unsigned vtr_addr = (unsigned)(size_t)(sVc) + (unsigned)((8 * kq + (l15 >> 2)) * 128 + (16 * vb + 4 * (l15 & 3)) * 2);
    const bf16* QE = WSP(const bf16, WS_QE); const bf16* KDT = WSP(const bf16, WS_KDT); const bf16* ATT = WSP(const bf16, WS_ATT); const float* DL = WSP(const float, WS_DL);
    bf16* GO = WSP(bf16, WS_GO);
    pg8::f32x4 S[4];
#pragma unroll
    for (int i = 0; i < 4; ++i) S[i] = (pg8::f32x4){0.f, 0.f, 0.f, 0.f};
    v4u vt[2]; pg8::f32x4 dl[4]; v4u vstage;
#define GLA_DMA(slot_, n_) do { const size_t u_ = ((size_t)b * 32 + (n_)) * 4 + h; _Pragma("unroll") for (int i = 0; i < 5; ++i) { const int blk = w + 8 * i; \
        const bf16* src = blk < 16 ? QE + (u_ * 16 + blk) * 512 : (blk < 24 ? ATT + (u_ * 8 + (blk - 16)) * 512 : KDT + (u_ * 16 + (blk - 24)) * 512); \
        __builtin_amdgcn_global_load_lds((const unsigned*)(src + lane * 8), (LAS unsigned*)(ring + (slot_) * 40960 + blk * 1024), 16, 0, 0); } } while (0)
#define GLA_FRAG(slot_, blk_) (*(const LAS v4u*)(ring + (slot_) * 40960 + (blk_) * 1024 + lane * 16))
#define GLA_LOAD_V(n_) do { vstage = *(const v4u*)(P + ((size_t)b * 2048 + (size_t)(n_) * 64 + vst) * NP + PC_V + h * 256 + vq * 64 + vsc * 8); } while (0)
#define GLA_STORE_V(buf_) do { *(LAS v4u*)(sVc + (buf_) * 8192 + vst * 128 + vsc * 16) = vstage; } while (0)
#define GLA_READ_VT(buf_) do { _Pragma("unroll") for (int ks = 0; ks < 2; ++ks) { v2u lo_, hi_; \
        asm volatile("ds_read_b64_tr_b16 %0, %1" : "=&v"(lo_) : "v"(vtr_addr + (buf_) * 8192 + ks * 4096) : "memory"); asm volatile("ds_read_b64_tr_b16 %0, %1" : "=&v"(hi_) : "v"(vtr_addr + (buf_) * 8192 + ks * 4096 + 512) : "memory"); \
        asm volatile("s_waitcnt lgkmcnt(0)" : "+v"(lo_), "+v"(hi_) :: "memory"); vt[ks].x = lo_.x; vt[ks].y = lo_.y; vt[ks].z = hi_.x; vt[ks].w = hi_.y; } } while (0)
#define GLA_LOAD_DL(n_) do { const size_t u_ = ((size_t)b * 32 + (n_)) * 4 + h; _Pragma("unroll") for (int dt = 0; dt < 4; ++dt) dl[dt] = *(const pg8::f32x4*)(DL + u_ * 128 + half * 64 + dt * 16 + kq * 4); } while (0)
    GLA_DMA(0, 0); GLA_LOAD_DL(0); GLA_LOAD_V(0); GLA_STORE_V(0);
    asm volatile("s_waitcnt vmcnt(0) lgkmcnt(0)" ::: "memory"); __builtin_amdgcn_s_barrier(); asm volatile("" ::: "memory");
    for (int n = 0; n < 32; ++n) {
        const size_t m0 = (size_t)b * 2048 + (size_t)n * 64; const int slot = n & 1;
        if (n + 1 < 32) { GLA_DMA(slot ^ 1, n + 1); GLA_LOAD_V(n + 1); }
        GLA_READ_VT(n & 1);
        v4u sf[2];
#pragma unroll
        for (int ks = 0; ks < 2; ++ks) { sf[ks].x = cvtpk(S[2 * ks][0], S[2 * ks][1]); sf[ks].y = cvtpk(S[2 * ks][2], S[2 * ks][3]); sf[ks].z = cvtpk(S[2 * ks + 1][0], S[2 * ks + 1][1]); sf[ks].w = cvtpk(S[2 * ks + 1][2], S[2 * ks + 1][3]); }
        pg8::f32x4 acc[4];
#pragma unroll
        for (int it = 0; it < 4; ++it) { acc[it] = (pg8::f32x4){0.f, 0.f, 0.f, 0.f};
            acc[it] = __builtin_amdgcn_mfma_f32_16x16x32_bf16(as_bf8(vt[half]), as_bf8(GLA_FRAG(slot, 16 + it * 2 + half)), acc[it], 0, 0, 0);
#pragma unroll
            for (int ks = 0; ks < 2; ++ks) acc[it] = __builtin_amdgcn_mfma_f32_16x16x32_bf16(as_bf8(sf[ks]), as_bf8(GLA_FRAG(slot, (it * 2 + half) * 2 + ks)), acc[it], 0, 0, 0); }
#pragma unroll
        for (int dt = 0; dt < 4; ++dt) { S[dt] = S[dt] * dl[dt];
#pragma unroll
            for (int ks = 0; ks < 2; ++ks) S[dt] = __builtin_amdgcn_mfma_f32_16x16x32_bf16(as_bf8(GLA_FRAG(slot, 24 + (half * 4 + dt) * 2 + ks)), as_bf8(vt[ks]), S[dt], 0, 0, 0); }
        if (n + 1 < 32) GLA_LOAD_DL(n + 1);
        const int buf = n & 1;
#pragma unroll
        for (int ii = 0; ii < 2; ++ii) sO[((buf * 8 + w) * 2 + ii) * 64 + lane] = half ? acc[ii] : acc[2 + ii];
        if (n + 1 < 32) GLA_STORE_V((n + 1) & 1);
        asm volatile("s_waitcnt vmcnt(0) lgkmcnt(0)" ::: "memory"); __builtin_amdgcn_s_barrier(); asm volatile("" ::: "memory");
#pragma unroll
        for (int ii = 0; ii < 2; ++ii) { const int t = half ? 2 + ii : ii; const pg8::f32x4 o = (half ? acc[2 + ii] : acc[ii]) + sO[((buf * 8 + (w ^ 4)) * 2 + ii) * 64 + lane];
            v2u ov; ov.x = cvtpk(o[0], o[1]); ov.y = cvtpk(o[2], o[3]);
            *(v2u*)(GO + (m0 + t * 16 + l15) * 1024 + h * 256 + vq * 64 + vb * 16 + kq * 4) = ov; }
    }
#undef GLA_DMA
#undef GLA_FRAG
#undef GLA_LOAD_V
#undef GLA_STORE_V
#undef GLA_READ_VT
#undef GLA_LOAD_DL
}


typedef float f32x2c __attribute__((ext_vector_type(2))); typedef __bf16 bf16x2c __attribute__((ext_vector_type(2)));
__device__ __forceinline__ unsigned cvtpk_(float lo, float hi) { const f32x2c v = {lo, hi}; const bf16x2c r = __builtin_convertvector(v, bf16x2c); return __builtin_bit_cast(unsigned, r); }
__device__ __forceinline__ unsigned cvtpk_a(float lo, float hi) { unsigned r; asm("v_cvt_pk_bf16_f32 %0, %1, %2" : "=v"(r) : "v"(lo), "v"(hi)); return r; }
__device__ __forceinline__ v4u opf1(const pg8::f32x4& x) { v4u r; r.x = cvtpk_(x[0], x[1]); r.y = cvtpk_(x[2], x[3]); r.z = 0u; r.w = 0u; return r; }
__device__ __forceinline__ v4u opf2(const pg8::f32x4& x, const pg8::f32x4& y) { v4u r; r.x = cvtpk_(x[0], x[1]); r.y = cvtpk_(x[2], x[3]); r.z = cvtpk_(y[0], y[1]); r.w = cvtpk_(y[2], y[3]); return r; }
#define RMF(a, b, c) __builtin_amdgcn_mfma_f32_16x16x32_bf16(as_bf8(a), as_bf8(b), (c), 0, 0, 0)
template <int N> __device__ __forceinline__ float dpp_shr_add(float x) { return x + __builtin_bit_cast(float, __builtin_amdgcn_update_dpp(0, __builtin_bit_cast(int, x), 0x110 + N, 0xf, 0xf, true)); }

__device__ __forceinline__ unsigned scale_pk(unsigned w, float s) { return cvtpk_a(blo(w) * s, bhi(w) * s); }
#ifdef NO_CSTORE
#define CST if (0)
#else
#define CST
#endif
#ifdef NO_CSTORE2
#define CST2 if (0)
#else
#define CST2
#endif
__device__ __forceinline__ void rwkv_chunk_ops(Frame& F, size_t unit, size_t m, int hd, int lane, float inv,
                                               const v4u (&kaf)[2], const v4u (&kbf)[2], const v4u (&rf)[2], const v4u (&kf)[2], const v4u (&vf)[2]) {
    const int l15 = lane & 15, kq = lane >> 4;
    const pg8::f32x4 z4 = {0.f, 0.f, 0.f, 0.f};
    v4u af[2], bfr[2];
#pragma unroll
    for (int s = 0; s < 2; ++s) { af[s].x = scale_pk(kaf[s].x, -inv); af[s].y = scale_pk(kaf[s].y, -inv); af[s].z = scale_pk(kaf[s].z, -inv); af[s].w = scale_pk(kaf[s].w, -inv);
        bfr[s].x = scale_pk(kbf[s].x, inv); bfr[s].y = scale_pk(kbf[s].y, inv); bfr[s].z = scale_pk(kbf[s].z, inv); bfr[s].w = scale_pk(kbf[s].w, inv); }
    pg8::f32x4 dN = RMF(bfr[1], af[1], RMF(bfr[0], af[0], z4)), dNt = RMF(af[1], bfr[1], RMF(af[0], bfr[0], z4)), dKAt = RMF(af[1], kf[1], RMF(af[0], kf[0], z4));
    pg8::f32x4 dNbr = RMF(bfr[1], rf[1], RMF(bfr[0], rf[0], z4)), dNkr = RMF(kf[1], rf[1], RMF(kf[0], rf[0], z4));
    pg8::f32x4 P, Pt;
#pragma unroll
    for (int e = 0; e < 4; ++e) { const int row = kq * 4 + e; const float idv = (row == l15) ? 1.f : 0.f;
        dN[e] = (row < l15) ? dN[e] : 0.f; dNt[e] = (l15 < row) ? dNt[e] : 0.f; dKAt[e] = (l15 < row) ? dKAt[e] : 0.f;
        dNbr[e] = (row <= l15) ? dNbr[e] : 0.f; dNkr[e] = (row <= l15) ? dNkr[e] : 0.f; P[e] = dN[e] + idv; Pt[e] = dNt[e] + idv; }
    { pg8::f32x4 X = dN, Xt = dNt;
#pragma unroll
      for (int it = 0; it < 3; ++it) { const v4u aX = opf1(X), aXt = opf1(Xt); const pg8::f32x4 X2 = RMF(aXt, aX, z4), X2t = RMF(aX, aXt, z4);
          const v4u aPt = opf1(Pt), aX2 = opf1(X2); P = RMF(aPt, aX2, P); Pt = RMF(aX2, aPt, Pt); X = X2; Xt = X2t; } }
    const v4u oT = opf1(P);
    const pg8::f32x4 M2 = RMF(opf1(Pt), opf1(dNbr), z4), P2 = RMF(opf1(dKAt), oT, z4);
    const v4u oM2 = opf1(M2), oP2 = opf1(P2), oNN = opf2(dNbr, dNkr);
    v4u sel[2];
#pragma unroll
    for (int p = 0; p < 2; ++p) { const int idx = 4 * p + (l15 & 3); const bool on = (l15 >> 2) == kq; unsigned wv[4] = {0u, 0u, 0u, 0u}; wv[idx >> 1] = on ? ((idx & 1) ? 0x3F800000u : 0x00003F80u) : 0u; sel[p].x = wv[0]; sel[p].y = wv[1]; sel[p].z = wv[2]; sel[p].w = wv[3]; }
    bf16* P1T = WSP(bf16, WS_P1T); bf16* Q1T = WSP(bf16, WS_Q1T); bf16* BKT = WSP(bf16, WS_BKT); bf16* VTR = WSP(bf16, WS_VTR); bf16* ULT = WSP(bf16, WS_ULT); bf16* RY = WSP(bf16, WS_RY);
    pg8::f32x4 p1prev, q1prev; v2u ryp[4];
#pragma unroll
    for (int j = 0; j < 4; ++j) { const int s = j >> 1, p = j & 1;
        const v4u oA = opf1(RMF(af[s], sel[p], z4));
        const unsigned rw0 = p ? rf[s].z : rf[s].x, rw1 = p ? rf[s].w : rf[s].y;
        const pg8::f32x4 p1 = RMF(oA, oT, z4), q1 = RMF(oA, oM2, ((pg8::f32x4){blo(rw0), bhi(rw0), blo(rw1), bhi(rw1)}));
        if (p) { CST *(v4u*)(P1T + ((unit * 2 + s) * 64 + lane) * 8) = opf2(p1prev, p1); CST *(v4u*)(Q1T + ((unit * 2 + s) * 64 + lane) * 8) = opf2(q1prev, q1); } else { p1prev = p1; q1prev = q1; }
        const pg8::f32x4 dB = RMF(bfr[s], sel[p], z4), dK = RMF(kf[s], sel[p], z4), dV = RMF(vf[s], sel[p], z4);
        CST *(v4u*)(BKT + ((unit * 4 + j) * 64 + lane) * 8) = opf2(dB, dK);
        const v4u oV = opf1(dV);
        CST *(v2u*)(VTR + ((unit * 4 + j) * 64 + lane) * 4) = (v2u){oV.x, oV.y};
        const pg8::f32x4 ul = RMF(oP2, oV, z4);
        const v4u oU = opf1(ul);
        CST *(v2u*)(ULT + ((unit * 4 + j) * 64 + lane) * 4) = (v2u){oU.x, oU.y};
        v4u aUV; aUV.x = oU.x; aUV.y = oU.y; aUV.z = oV.x; aUV.w = oV.y;
        const pg8::f32x4 yl = RMF(aUV, oNN, z4);
        ryp[j] = (v2u){cvtpk_(yl[0], yl[1]), cvtpk_(yl[2], yl[3])};
        __builtin_amdgcn_sched_barrier(0); }
#pragma unroll
    for (int j = 0; j < 4; ++j) *(v2u*)(RY + m * 512 + hd * 64 + j * 16 + kq * 4) = ryp[j];
}

__device__ __forceinline__ void rwkv_seq_body(Frame& F, const bf16* __restrict__ RYr, bf16* __restrict__ RYw) {
    if (F.vcu >= 128 || F.wave >= 4) return;
    const int b = F.vcu >> 3, h = F.vcu & 7, vb = F.wave, lane = F.lane, l15 = lane & 15, kq = lane >> 4;
    const bf16* P1T = WSP(const bf16, WS_P1T); const bf16* Q1T = WSP(const bf16, WS_Q1T); const bf16* BKT = WSP(const bf16, WS_BKT); const bf16* VTR = WSP(const bf16, WS_VTR); const bf16* ULT = WSP(const bf16, WS_ULT);
    const float* WC = WSP(const float, WS_WC);
    pg8::f32x4 St[4];
#pragma unroll
    for (int j = 0; j < 4; ++j) St[j] = (pg8::f32x4){0.f, 0.f, 0.f, 0.f};
    v4u p1[2][2], q1[2][2], bk[2][4]; v2u vt[2], ul[2], ry[2]; f32x4 wc[2][4];
#define RS_LOAD(S_, n_) do { const size_t u_ = ((size_t)b * 128 + (n_)) * 8 + h; \
        _Pragma("unroll") for (int s = 0; s < 2; ++s) { p1[S_][s] = *(const v4u*)(P1T + ((u_ * 2 + s) * 64 + lane) * 8); q1[S_][s] = *(const v4u*)(Q1T + ((u_ * 2 + s) * 64 + lane) * 8); } \
        _Pragma("unroll") for (int j = 0; j < 4; ++j) { bk[S_][j] = *(const v4u*)(BKT + ((u_ * 4 + j) * 64 + lane) * 8); wc[S_][j] = *(const f32x4*)(WC + u_ * 64 + j * 16 + kq * 4); } \
        vt[S_] = *(const v2u*)(VTR + ((u_ * 4 + vb) * 64 + lane) * 4); ul[S_] = *(const v2u*)(ULT + ((u_ * 4 + vb) * 64 + lane) * 4); \
        ry[S_] = *(const v2u*)(RYr + ((size_t)b * 2048 + (size_t)(n_) * 16 + l15) * 512 + h * 64 + vb * 16 + kq * 4); } while (0)
#define RS_STEP(S_, n_) do { \
        const v4u sf0 = opf2(St[0], St[1]), sf1 = opf2(St[2], St[3]); \
        pg8::f32x4 U = {blo(ul[S_].x), bhi(ul[S_].x), blo(ul[S_].y), bhi(ul[S_].y)}; \
        U = RMF(p1[S_][0], sf0, U); U = RMF(p1[S_][1], sf1, U); \
        pg8::f32x4 Y = {blo(ry[S_].x), bhi(ry[S_].x), blo(ry[S_].y), bhi(ry[S_].y)}; \
        Y = RMF(sf0, q1[S_][0], Y); Y = RMF(sf1, q1[S_][1], Y); \
        *(v2u*)(RYw + ((size_t)b * 2048 + (size_t)(n_) * 16 + l15) * 512 + h * 64 + vb * 16 + kq * 4) = (v2u){cvtpk_(Y[0], Y[1]), cvtpk_(Y[2], Y[3])}; \
        v4u uf; uf.x = cvtpk_(U[0], U[1]); uf.y = cvtpk_(U[2], U[3]); uf.z = vt[S_].x; uf.w = vt[S_].y; \
        _Pragma("unroll") for (int j = 0; j < 4; ++j) { St[j] = RMF(bk[S_][j], uf, St[j]); St[j][0] *= wc[S_][j].x; St[j][1] *= wc[S_][j].y; St[j][2] *= wc[S_][j].z; St[j][3] *= wc[S_][j].w; } } while (0)
    RS_LOAD(0, 0); RS_LOAD(1, 1);
    for (int n = 0; n < 128; n += 2) {
        RS_STEP(0, n); __builtin_amdgcn_sched_barrier(0); if (n + 2 < 128) RS_LOAD(0, n + 2); __builtin_amdgcn_sched_barrier(0);
        RS_STEP(1, n + 1); __builtin_amdgcn_sched_barrier(0); if (n + 3 < 128) RS_LOAD(1, n + 3); __builtin_amdgcn_sched_barrier(0);
    }
#undef RS_STEP
#undef RS_LOAD
}
__device__ __forceinline__ void phase_rwkv_seq(Frame& F, const Args& A) { rwkv_seq_body(F, WSP(const bf16, WS_RY), WSP(bf16, WS_RY)); }

__device__ __forceinline__ void phase_rwkv_prep3(Frame& F, const Args& A, int l) {
    const int gw = F.vcu * NWAVES + F.wave, lane = F.lane, tid = F.tid, l15 = lane & 15, kq = lane >> 4;
    const size_t m = (size_t)gw * 16 + l15; const bool first = (m & 2047) == 0; const size_t mp = first ? m : m - 1;
    const bf16* P = WSP(const bf16, WS_P); const float* mu = A.in[11] + (size_t)l * 1792;
    const bf16* LF = WSP(const bf16, WS_W2T);
    bf16* RV = WSP(bf16, WS_RV); bf16* RG = WSP(bf16, WS_RG);
    float* BC = WSP(float, WS_BC);
    LAS unsigned char* wbuf = F.lds;
    LAS float* cbuf = (LAS float*)(F.lds + 65536);
    const float* cptr; { const int arr = tid >> 6, ch = tid & 63;
        cptr = arr == 0 ? A.in[12] + (size_t)l * 512 + ch : arr == 1 ? A.in[14] + (size_t)l * 512 + ch : arr == 2 ? A.in[17] + (size_t)l * 512 + ch : arr == 3 ? A.in[18] + (size_t)l * 512 + ch :
               arr == 4 ? A.in[19] + (size_t)l * 512 + ch : arr == 5 ? mu + ch : arr == 6 ? mu + 576 + ch : mu + 1088 + ch; }
    float g_c;
#define RP_ISSUE(hd_, buf_) do { _Pragma("unroll") for (int i = 0; i < 4; ++i) __builtin_amdgcn_global_load_lds((const unsigned*)(LF + ((size_t)(hd_) * 2048 + (i * 8 + F.wave) * 64 + lane) * 8), (LAS unsigned*)(wbuf + (buf_) * 32768 + (i * 8 + F.wave) * 1024), 16, 0, 0); g_c = cptr[(hd_) * 64]; } while (0)
#define RP_WRITE(buf_) do { cbuf[(buf_) * 512 + tid] = g_c; } while (0)
    RP_ISSUE(0, 0);
    const v4u zero4 = {0u, 0u, 0u, 0u}; const v2u z2 = {0u, 0u};
    LAS unsigned char* xfl = F.lds + 69632 + F.wave * 8192 + lane * 16;
#pragma unroll
    for (int f = 0; f < 8; ++f) { int pc, mi; if (f < 2) { pc = PC_WD + f * 32; mi = 512 + f * 32; } else if (f < 4) { pc = PC_AD + (f - 2) * 32; mi = 1600 + (f - 2) * 32; } else { pc = PC_GD + (f - 4) * 32; mi = 1664 + (f - 4) * 32; }
        pc += kq * 8; mi += kq * 8;
        const v4u cu = *(const v4u*)(P + m * NP + pc); const v4u pr = first ? zero4 : *(const v4u*)(P + (m - 1) * NP + pc);
        const f32x4 mu0 = *(const f32x4*)(mu + mi), mu1 = *(const f32x4*)(mu + mi + 4);
        float c[8] = {blo(cu.x), bhi(cu.x), blo(cu.y), bhi(cu.y), blo(cu.z), bhi(cu.z), blo(cu.w), bhi(cu.w)};
        float p[8] = {blo(pr.x), bhi(pr.x), blo(pr.y), bhi(pr.y), blo(pr.z), bhi(pr.z), blo(pr.w), bhi(pr.w)};
        float mm[8] = {mu0.x, mu0.y, mu0.z, mu0.w, mu1.x, mu1.y, mu1.z, mu1.w};
#pragma unroll
        for (int j = 0; j < 8; ++j) { const float xs = c[j] + (p[j] - c[j]) * mm[j]; c[j] = f < 2 ? tanhf_(xs) : (f < 4 ? xs : sigmoidf_(xs)); }
        v4u xv; xv.x = pk2(c[0], c[1]); xv.y = pk2(c[2], c[3]); xv.z = pk2(c[4], c[5]); xv.w = pk2(c[6], c[7]); *(LAS v4u*)(xfl + f * 1024) = xv; }
    v2u pc_[4][3], pp_[4][3];
#define RP_LOADH(hd_) do { _Pragma("unroll") for (int j_ = 0; j_ < 4; ++j_) { const int c0_ = ((hd_) * 4 + j_) * 16 + kq * 4; \
        pc_[j_][0] = *(const v2u*)(P + m * NP + PC_R + c0_); pc_[j_][1] = *(const v2u*)(P + m * NP + PC_RK + c0_); pc_[j_][2] = *(const v2u*)(P + m * NP + PC_RV + c0_); \
        pp_[j_][0] = *(const v2u*)(P + mp * NP + PC_R + c0_); pp_[j_][1] = *(const v2u*)(P + mp * NP + PC_RK + c0_); pp_[j_][2] = *(const v2u*)(P + mp * NP + PC_RV + c0_); \
        if (first) { pp_[j_][0] = z2; pp_[j_][1] = z2; pp_[j_][2] = z2; } } } while (0)
    RP_WRITE(0);
    asm volatile("s_waitcnt vmcnt(0)" ::: "memory");
    __syncthreads();
    for (int hd = 0; hd < 8; ++hd) {
        const int buf = hd & 1;
        if (hd + 1 < 8) RP_ISSUE(hd + 1, buf ^ 1);
        RP_LOADH(hd);
        const LAS unsigned char* wb = wbuf + buf * 32768 + lane * 16; const LAS float* cb = cbuf + buf * 512;
        v4u kaf[2], kbf[2], rf[2], kf[2], vf[2]; v2u rvp[4], rgp[4]; float ssq = 0.f, bcs = 0.f;
#pragma unroll
        for (int j = 0; j < 4; ++j) { const int ct = hd * 4 + j, c0 = ct * 16 + kq * 4, cl = j * 16 + kq * 4;
            const v2u cr = pc_[j][0], ck = pc_[j][1], cv = pc_[j][2], pr = pp_[j][0], pk = pp_[j][1], pv = pp_[j][2];
            pg8::f32x4 aw = {0.f, 0.f, 0.f, 0.f}, aa = aw, ag = aw;
#pragma unroll
            for (int ks = 0; ks < 2; ++ks) { aw = __builtin_amdgcn_mfma_f32_16x16x32_bf16(as_bf8(*(const LAS v4u*)(wb + (j * 8 + ks) * 1024)), as_bf8(*(const LAS v4u*)(xfl + ks * 1024)), aw, 0, 0, 0);
                                              aa = __builtin_amdgcn_mfma_f32_16x16x32_bf16(as_bf8(*(const LAS v4u*)(wb + (j * 8 + 2 + ks) * 1024)), as_bf8(*(const LAS v4u*)(xfl + (2 + ks) * 1024)), aa, 0, 0, 0); }
#pragma unroll
            for (int ks = 0; ks < 4; ++ks) ag = __builtin_amdgcn_mfma_f32_16x16x32_bf16(as_bf8(*(const LAS v4u*)(wb + (j * 8 + 4 + ks) * 1024)), as_bf8(*(const LAS v4u*)(xfl + (4 + ks) * 1024)), ag, 0, 0, 0);
            const f32x4 w0 = *(const LAS f32x4*)(cb + cl), a0 = *(const LAS f32x4*)(cb + 64 + cl), kkc = *(const LAS f32x4*)(cb + 128 + cl), kac = *(const LAS f32x4*)(cb + 192 + cl), rkc = *(const LAS f32x4*)(cb + 256 + cl);
            const f32x4 mur = *(const LAS f32x4*)(cb + 320 + cl), muk = *(const LAS f32x4*)(cb + 384 + cl), muv = *(const LAS f32x4*)(cb + 448 + cl);
            const float crf[4] = {blo(cr.x), bhi(cr.x), blo(cr.y), bhi(cr.y)}, ckf[4] = {blo(ck.x), bhi(ck.x), blo(ck.y), bhi(ck.y)}, cvf[4] = {blo(cv.x), bhi(cv.x), blo(cv.y), bhi(cv.y)};
            const float prf[4] = {blo(pr.x), bhi(pr.x), blo(pr.y), bhi(pr.y)}, pkf[4] = {blo(pk.x), bhi(pk.x), blo(pk.y), bhi(pk.y)}, pvf[4] = {blo(pv.x), bhi(pv.x), blo(pv.y), bhi(pv.y)};
            float vo[4], go[4], kt_[4], wcv[4], rt_[4], ka_[4], kb_[4];
#pragma unroll
            for (int e = 0; e < 4; ++e) { const float r = crf[e] + (prf[e] - crf[e]) * mur[e], k = ckf[e] + (pkf[e] - ckf[e]) * muk[e], v = cvf[e] + (pvf[e] - cvf[e]) * muv[e];
                const float wl = -softplusf_(-(w0[e] + aw[e])) - 0.5f; const float lw = -fexp_(wl);
                const float a = sigmoidf_(a0[e] + aa[e]); const float kk = k * kkc[e]; const float km = k * (1.0f + (a - 1.0f) * kac[e]);
                ssq += kk * kk; bcs += r * km * rkc[e];
                float c = lw; c = dpp_shr_add<1>(c); c = dpp_shr_add<2>(c); c = dpp_shr_add<4>(c); c = dpp_shr_add<8>(c);
                const float E = fexp_(c), Ei = fexp_(-c), Ep = fexp_(c - lw);
                rt_[e] = r * E; kt_[e] = km * Ei; ka_[e] = kk * Ep; kb_[e] = kk * a * Ei;
                vo[e] = v; go[e] = ag[e];
                wcv[e] = E; }
            if (l15 == 15) *(f32x4*)(WSP(float, WS_WC) + ((size_t)gw * 8 + hd) * 64 + j * 16 + kq * 4) = (f32x4){wcv[0], wcv[1], wcv[2], wcv[3]};
            { const int s = j >> 1; const unsigned r0 = cvtpk_a(rt_[0], rt_[1]), r1 = cvtpk_a(rt_[2], rt_[3]), a0_ = cvtpk_a(ka_[0], ka_[1]), a1_ = cvtpk_a(ka_[2], ka_[3]), b0_ = cvtpk_a(kb_[0], kb_[1]), b1_ = cvtpk_a(kb_[2], kb_[3]), k0 = cvtpk_a(kt_[0], kt_[1]), k1 = cvtpk_a(kt_[2], kt_[3]), v0 = cvtpk_a(vo[0], vo[1]), v1 = cvtpk_a(vo[2], vo[3]);
              if (j & 1) { rf[s].z = r0; rf[s].w = r1; kf[s].z = k0; kf[s].w = k1; vf[s].z = v0; vf[s].w = v1; kaf[s].z = a0_; kaf[s].w = a1_; kbf[s].z = b0_; kbf[s].w = b1_; }
              else { rf[s].x = r0; rf[s].y = r1; kf[s].x = k0; kf[s].y = k1; vf[s].x = v0; vf[s].y = v1; kaf[s].x = a0_; kaf[s].y = a1_; kbf[s].x = b0_; kbf[s].y = b1_; } }
            __builtin_amdgcn_sched_barrier(0);
            const size_t o = m * 512 + c0;
            rvp[j] = (v2u){pk2(vo[0], vo[1]), pk2(vo[2], vo[3])}; rgp[j] = (v2u){pk2(go[0], go[1]), pk2(go[2], go[3])}; (void)o; }
#pragma unroll
        for (int j = 0; j < 4; ++j) { const size_t o = m * 512 + (hd * 4 + j) * 16 + kq * 4; *(v2u*)(RV + o) = rvp[j]; *(v2u*)(RG + o) = rgp[j]; }
        ssq += __shfl_xor(ssq, 16); ssq += __shfl_xor(ssq, 32); bcs += __shfl_xor(bcs, 16); bcs += __shfl_xor(bcs, 32);
        const float inv = __builtin_amdgcn_rsqf(fmaxf(ssq, 1e-24f));
#ifndef NO_COPS
        rwkv_chunk_ops(F, (size_t)gw * 8 + hd, m, hd, lane, inv, kaf, kbf, rf, kf, vf);
#endif
        if (kq == 0) BC[m * 8 + hd] = bcs;
        if (hd + 1 < 8) RP_WRITE(buf ^ 1);
        asm volatile("s_waitcnt vmcnt(0)" ::: "memory");
        __syncthreads();
    }
#undef RP_ISSUE
#undef RP_WRITE
#undef RP_LOADH
}

enum Phase { PH_CONV = 0, PH_NORM1, PH_GEMM_IN, PH_PREP, PH_GLASCAN, PH_RWSCAN, PH_POST, PH_GEMM_GLAO, PH_GEMM_RWO, PH_GEMM_OUT, PH_NORM2, PH_ROUTE2, PH_GEMM_UP, PH_GEMM_DN, PH_COMBINE, PH_FINAL, PH_COUNT };

__global__ void __launch_bounds__(NWAVES * 64, 2) mk_fwd(Args args) {
    extern __shared__ __attribute__((aligned(16))) unsigned char lds[];
    Frame F;
    F.lds = (LAS unsigned char*)lds;
    F.MISC = (volatile LAS unsigned*)(F.lds + MISC_OFF);
    F.tid = threadIdx.x; F.lane = F.tid & 63; F.wave = __builtin_amdgcn_readfirstlane(F.tid >> 6);
    F.G = gridDim.x; { const int bx = blockIdx.x; F.vcu = (F.G % 8 == 0) ? (bx % 8) * (F.G / 8) + bx / 8 : bx; }
    F.out = args.out; F.ws = args.ws;
    for (int u = F.tid; u < (LDS_BYTES - LDSCTL_OFF) / 4; u += NWAVES * 64) ((LAS unsigned*)(F.lds + LDSCTL_OFF))[u] = 0u;
    __syncthreads();
    const int fused = args.fused; const bool dry = args.pad != 0;
    float* xdry = (float*)(F.ws + 772 * MiB); bf16* hdry = (bf16*)(F.ws + 900 * MiB);
    XcdBarrier bar; bar.bar = (unsigned*)(F.ws + WS_CTL) + CW_BAR; bar.x = 0; bar.st = nullptr;
    if (fused) bar = xcd_barrier_post((unsigned*)(F.ws + WS_CTL) + CW_BAR, F.MISC + 8);
    const int lo = args.ph_lo, hi = args.ph_hi;
#ifndef NO_D1
#define NO_D1 0
#endif
#ifndef NO_R1
#define NO_R1 0
#endif
#ifndef PHMASK
#define PHMASK 0xFFFFF
#endif
#define IN(k) (((PHMASK >> (k)) & 1) && lo <= (k) && (k) < hi)
#define PB() do { int t_ = threadIdx.x; asm volatile("" : "+v"(t_)); F.tid = t_; F.lane = t_ & 63; F.wave = __builtin_amdgcn_readfirstlane(t_ >> 6); } while (0)
#define SEAM() do { if (fused) xcd_barrier(bar); } while (0)
    PG8_LAS unsigned char* ring = (PG8_LAS unsigned char*)(F.lds + RING_OFF);

    for (int l = args.l_lo; l < args.l_hi; ++l) {
        const bool moe = (l & 1);
        const float* xin = (l == 0) ? args.in[0] : (const float*)F.out;

        if (IN(PH_CONV)) { PB(); if (l == 0) phase_mod(F, args); phase_conv(F, args, l); if (l == 0 || !fused) SEAM(); else __syncthreads(); }

        if (IN(PH_NORM1) && !(l > 0 && ((l - 1) & 1))) { PB(); phase_norm<0>(F, args, l, xin, l > 0); SEAM(); }

        if (IN(PH_GEMM_IN)) { PB();
            pg8::Gemm g{WSP(const bf16, WS_H), WSP(const bf16, WS_WIN), M, NPW, D}; pg8::StaticOrder S; S.init(M, NPW, F.G, (int)blockIdx.x);
            pg8::EpiPlainGate E{WSP(bf16, WS_P), NP, NP / 256, WSP(bf16, WS_GATE), (size_t)M * 1024};
            pg8::gemm_phase<pg8::EpiPlainGate, pg8::StaticOrder, true, true>(ring, g, S, E);
            SEAM();
        }

        if (IN(PH_PREP)) { PB(); if (!fused) phase_gla_d1(F, args, l, F.vcu, 256); if (!NO_R1) phase_rwkv_prep3(F, args, l); SEAM(); }
        if (IN(PH_RWSCAN)) { PB(); if (fused && F.vcu >= 128) phase_gla_d1(F, args, l, F.vcu - 128, 128); else phase_rwkv_seq(F, args); SEAM(); }
        if (IN(PH_GLASCAN)) { PB(); phase_gla_d2(F, args); SEAM(); }

        if (IN(PH_POST)) { PB(); phase_post(F, args, l, dry); SEAM(); }

        if (IN(PH_GEMM_GLAO)) { PB();
            pg8::Gemm g{WSP(const bf16, WS_GO), WSP(const bf16, WS_GLAO), M, D, D}; pg8::StaticOrder S; S.init(M, D, F.G, (int)blockIdx.x);
            pg8::EpiGate E{nullptr, WSP(bf16, WS_H), nullptr, WSP(const bf16, WS_GATE), D};
            pg8::gemm_phase<pg8::EpiGate, pg8::StaticOrder, true, true>(ring, g, S, E);
            VM_WAIT(); __syncthreads();
        }

        if (IN(PH_GEMM_RWO)) { PB();
            pg8::Gemm g{WSP(const bf16, WS_RY), WSP(const bf16, WS_RWO), M, D, 512}; pg8::StaticOrder S; S.init(M, D, F.G, (int)blockIdx.x);
            pg8::EpiGate E{WSP(bf16, WS_MG), nullptr, WSP(const bf16, WS_H), WSP(const bf16, WS_GATE) + (size_t)M * 1024, D};
            pg8::gemm_phase<pg8::EpiGate, pg8::StaticOrder, true, true>(ring, g, S, E);
            SEAM();
        }

        if (IN(PH_GEMM_OUT)) { PB();
            pg8::Gemm g{WSP(const bf16, WS_MG), WSP(const bf16, WS_WOUT), M, D, D}; pg8::StaticOrder S; S.init(M, D, F.G, (int)blockIdx.x);
            pg8::EpiDelta E{WSP(bf16, WS_H), args.in[3] + (size_t)l * 6144 + 2048, WSP(const float, WS_MODP) + (size_t)l * 16 * 6144 + 2048, (size_t)4 * 16 * 6144};
            pg8::gemm_phase<pg8::EpiDelta, pg8::StaticOrder, true, true>(ring, g, S, E);
            SEAM();
        }

        if (IN(PH_NORM2)) { PB(); if (moe) phase_norm<2>(F, args, l, xin, true); else phase_norm<1>(F, args, l, xin, true); SEAM(); }

        if (moe) {
            if (IN(PH_ROUTE2)) { PB(); phase_route2(F, args); SEAM(); }
            if (IN(PH_GEMM_UP)) { PB();
                const int nT = __builtin_amdgcn_readfirstlane(((const int*)(F.ws + WS_MOE + MO_NT))[0]);
                pg8::Gemm g{WSP(const bf16, WS_HA), WSP(const bf16, WS_MUP), nT * 256, 2 * MFF, D}; pg8::MoeOrder S; S.init_moe(nT, 2 * MFF / 256, F.G, (int)blockIdx.x, (const int*)(F.ws + WS_MOE + MO_TILE));
                pg8::EpiSwiglu E{WSP(bf16, WS_U), MFF, 2 * MFF / 256};
                pg8::gemm_phase<pg8::EpiSwiglu, pg8::MoeOrder, true, true>(ring, g, S, E);
                SEAM();
            }
            if (IN(PH_GEMM_DN)) { PB();
                const int nT = __builtin_amdgcn_readfirstlane(((const int*)(F.ws + WS_MOE + MO_NT))[0]);
                pg8::Gemm g{WSP(const bf16, WS_U), WSP(const bf16, WS_MDN), nT * 256, D, MFF}; pg8::MoeOrder S; S.init_moe(nT, D / 256, F.G, (int)blockIdx.x, (const int*)(F.ws + WS_MOE + MO_TILE));
                pg8::EpiPlain E{WSP(bf16, WS_HA), D, D / 256};
                pg8::gemm_phase<pg8::EpiPlain, pg8::MoeOrder, true, true>(ring, g, S, E);
                SEAM();
            }
            if (IN(PH_COMBINE)) { PB(); phase_combine(F, args, l, dry); SEAM(); }
        } else {
            if (IN(PH_GEMM_UP)) { PB();
                pg8::Gemm g{WSP(const bf16, WS_H), WSP(const bf16, WS_FUP), M, 2 * FFN, D}; pg8::StaticOrder S; S.init(M, 2 * FFN, F.G, (int)blockIdx.x);
                pg8::EpiSwiglu E{WSP(bf16, WS_U), FFN, 1 << 20};
                pg8::gemm_phase<pg8::EpiSwiglu, pg8::StaticOrder, true, true>(ring, g, S, E);
                SEAM();
            }
            if (IN(PH_GEMM_DN)) { PB();
                pg8::Gemm g{WSP(const bf16, WS_U), WSP(const bf16, WS_FDN), M, D, FFN}; pg8::StaticOrder S; S.init(M, D, F.G, (int)blockIdx.x);
                pg8::EpiDelta E{WSP(bf16, WS_H), args.in[3] + (size_t)l * 6144 + 5120, WSP(const float, WS_MODP) + (size_t)l * 16 * 6144 + 5120, (size_t)4 * 16 * 6144};
                pg8::gemm_phase<pg8::EpiDelta, pg8::StaticOrder, true, true>(ring, g, S, E);
                SEAM();
            }
        }
        if (l == DEPTH - 1 && !moe && IN(PH_FINAL)) { PB(); phase_final(F, args); }
    }
#undef IN
#undef SEAM
}

extern "C" void kernel_launch(void* const* d_in, const int* in_sizes, int n_in, void* d_out, int out_size, void* d_ws, size_t ws_size, hipStream_t stream) {
    static int grid = 0;
    if (grid == 0) {
        if (n_in != 32 || in_sizes[0] != M * D || out_size != M * D || ws_size < WS_END) { fprintf(stderr, "kernel_launch: unexpected shapes / workspace (n_in %d, ws %zu, need %zu); nothing launched\n", n_in, ws_size, (size_t)WS_END); grid = -1; return; }
        int dev = 0, cus = 0, per_cu = 0;
        if (hipGetDevice(&dev) != hipSuccess || hipDeviceGetAttribute(&cus, hipDeviceAttributeMultiprocessorCount, dev) != hipSuccess) { grid = -1; return; }
        if (hipFuncSetAttribute((const void*)mk_fwd, hipFuncAttributeMaxDynamicSharedMemorySize, LDS_BYTES) != hipSuccess) { fprintf(stderr, "kernel_launch: hipFuncSetAttribute failed\n"); grid = -1; return; }
        if (hipOccupancyMaxActiveBlocksPerMultiprocessor(&per_cu, (const void*)mk_fwd, NWAVES * 64, LDS_BYTES) != hipSuccess || per_cu < 1) fprintf(stderr, "kernel_launch: occupancy query reports %d\n", per_cu);
        (void)hipGetLastError();
        grid = 256;
        if (cus < 256) { fprintf(stderr, "kernel_launch: %d CUs < 256; nothing launched\n", cus); grid = -1; return; }
    }
    if (grid < 0) return;
    if (hipMemsetAsync((char*)d_ws + WS_CTL, 0, CTL_ZERO_BYTES, stream) != hipSuccess) return;
    Args a{};
    for (int i = 0; i < 32; ++i) a.in[i] = (const float*)d_in[i];
    a.out = (float*)d_out; a.ws = (unsigned char*)d_ws;
#if MK_FUSED
    a.l_lo = 0; a.l_hi = DEPTH; a.ph_lo = 0; a.ph_hi = PH_COUNT; a.fused = 1;
    hipLaunchKernelGGL(mk_fwd, dim3(grid), dim3(NWAVES * 64), LDS_BYTES, stream, a);
#else
    for (int l = 0; l < DEPTH; ++l)
        for (int pi = 0; pi < PH_COUNT; ++pi) {
            const int ph = (pi == PH_GLASCAN) ? PH_RWSCAN : (pi == PH_RWSCAN) ? PH_GLASCAN : pi;
            if (!(l & 1) && (ph == PH_ROUTE2 || ph == PH_COMBINE)) continue;
            if (ph == PH_FINAL) continue;
            if (ph == PH_NORM1 && l > 0 && ((l - 1) & 1)) continue;
            a.l_lo = l; a.l_hi = l + 1; a.ph_lo = ph; a.ph_hi = ph + 1; a.fused = 0;
#ifndef REPMASK
#define REPMASK 0
#endif
            const bool inplace = (ph == PH_POST || ph == PH_COMBINE);
            const bool norep = (ph == PH_FINAL || ph == PH_NORM1 || ph == PH_NORM2 || (ph == PH_RWSCAN));
            const int nrep = (((REPMASK >> ph) & 1) && !norep) ? 2 : 1;
            for (int rep = 0; rep < nrep; ++rep) { a.pad = (inplace && nrep == 2 && rep == 0) ? 1 : 0;
            hipLaunchKernelGGL(mk_fwd, dim3(grid), dim3(NWAVES * 64), LDS_BYTES, stream, a); }
        }
#endif
}
```

```cpp
#include <hip/hip_runtime.h>
#include <cstdio>
#include <cstdint>
#ifndef MK_FUSED
#define MK_FUSED 1
#endif
namespace pg8 {
#define PG8_LAS __attribute__((address_space(3)))
typedef unsigned short bf16_t;
typedef short bf16x8 __attribute__((ext_vector_type(8)));
typedef float f32x4 __attribute__((ext_vector_type(4)));
typedef unsigned u32x4 __attribute__((ext_vector_type(4)));
constexpr int BM = 256, BK = 64, HALF = 128, HTB = HALF * BK * 2  , STAGE_BYTES = 8 * HTB, NXCD = 8, WGM = 4;

__host__ __device__ __forceinline__ int lds_byte(int r, int c) { const int st = (r >> 4) * 2 + (c >> 5), rr = r & 15, cc = c & 31, ob = rr * 64 + cc * 2; return st * 1024 + (ob ^ (((ob >> 9) & 1) << 5)); }
__host__ __device__ __forceinline__ void stage_rc(int b, int& R, int& C) { const int st = b / 1024, sb = b % 1024, swz = sb ^ (((sb >> 9) & 1) << 5); R = (st >> 1) * 16 + swz / 64; C = (st & 1) * 32 + (swz % 64) / 2; }
__host__ __device__ __forceinline__ int perm32(int rho) { const int n = rho >> 4, i = rho & 15; return 8 * (i >> 2) + 4 * n + (i & 3); }

struct Unit { int pm, pn; };
struct Gemm { const bf16_t* A; const bf16_t* Bt; int M, N, K; };

struct StaticOrder {
    int nM, nN, nwg, G, c;
    __host__ __device__ void init(int M, int N, int G_, int c_) { nM = M / BM; nN = N / BM; nwg = nM * nN; G = G_; c = c_; }
    __host__ __device__ bool next(int i, Unit& u) const {
        const long L = (long)i * G + c; if (L >= nwg) return false;
        int wgid = (int)L; { const int q = nwg / NXCD, r = nwg % NXCD, xcd = wgid % NXCD, off = wgid / NXCD; wgid = (xcd < r ? xcd * (q + 1) : r * (q + 1) + (xcd - r) * q) + off; }
        const int nig = WGM * nN, gid = wgid / nig, fm = gid * WGM, gsz = (nM - fm) < WGM ? (nM - fm) : WGM;
        u.pm = fm + ((wgid % nig) % gsz); u.pn = (wgid % nig) / gsz; return true;
    }
    __device__ __forceinline__ void a_ready(const Unit&) const {}
    __device__ __forceinline__ void done(const Unit&) const {}
};
typedef float f32x2p __attribute__((ext_vector_type(2))); typedef __bf16 bf16x2p __attribute__((ext_vector_type(2)));
__device__ __forceinline__ unsigned cvt_pk_bf16(float lo, float hi) { const f32x2p v = {lo, hi}; const bf16x2p r = __builtin_convertvector(v, bf16x2p); return __builtin_bit_cast(unsigned, r); }
typedef float f32x2 __attribute__((ext_vector_type(2)));

__device__ __forceinline__ float bf_lo(unsigned w) { return __uint_as_float(w << 16); }
__device__ __forceinline__ float bf_hi(unsigned w) { return __uint_as_float(w & 0xffff0000u); }
__device__ __forceinline__ float fsigmoid(float x) { return __builtin_amdgcn_rcpf(1.0f + __builtin_amdgcn_exp2f(-1.4426950408889634f * x)); }
__device__ __forceinline__ float fsilu(float x) { return x * fsigmoid(x); }

struct EpiPlain {
    static constexpr bool PERM = true, AFTER_DRAIN = false;
    bf16_t* O; int ldc; int pn_mod;
    __device__ __forceinline__ void operator()(const f32x4 (&acc)[2][2][4][2], const Unit& u, int wr, int wc, int fr, int fq) const {
        const int row0 = u.pm * BM + wr * 64 + fr, col0 = (u.pn % pn_mod) * BM + wc * 32 + 8 * fq;
#pragma unroll
        for (int ai = 0; ai < 2; ++ai)
#pragma unroll
            for (int m = 0; m < 4; ++m) { bf16_t* rowp = O + (size_t)(row0 + ai * HALF + m * 16) * ldc + col0;
#pragma unroll
                for (int bj = 0; bj < 2; ++bj) { const f32x4 v0 = acc[ai][bj][m][0], v1 = acc[ai][bj][m][1];
                    u32x4 w; w.x = cvt_pk_bf16(v0[0], v0[1]); w.y = cvt_pk_bf16(v0[2], v0[3]); w.z = cvt_pk_bf16(v1[0], v1[1]); w.w = cvt_pk_bf16(v1[2], v1[3]);
                    *(u32x4*)(rowp + bj * HALF) = w; } }
    }
};
struct EpiPlainGate {
    static constexpr bool PERM = true, AFTER_DRAIN = false;
    bf16_t* O; int ldc; int gtile0; bf16_t* G; size_t gstride;
    __device__ __forceinline__ void operator()(const f32x4 (&acc)[2][2][4][2], const Unit& u, int wr, int wc, int fr, int fq) const {
        if (u.pn < gtile0) {
            const int row0 = u.pm * BM + wr * 64 + fr, col0 = u.pn * BM + wc * 32 + 8 * fq;
#pragma unroll
            for (int ai = 0; ai < 2; ++ai)
#pragma unroll
                for (int m = 0; m < 4; ++m) { bf16_t* rowp = O + (size_t)(row0 + ai * HALF + m * 16) * ldc + col0;
#pragma unroll
                    for (int bj = 0; bj < 2; ++bj) { const f32x4 v0 = acc[ai][bj][m][0], v1 = acc[ai][bj][m][1];
                        u32x4 w; w.x = cvt_pk_bf16(v0[0], v0[1]); w.y = cvt_pk_bf16(v0[2], v0[3]); w.z = cvt_pk_bf16(v1[0], v1[1]); w.w = cvt_pk_bf16(v1[2], v1[3]);
                        *(u32x4*)(rowp + bj * HALF) = w; } }
        } else {
            const int gi = u.pn - gtile0, wave = wr * 4 + wc, lane = fr + 16 * fq;
            bf16_t* gp = G + (size_t)(gi >> 2) * gstride + ((size_t)((u.pm * 4 + (gi & 3)) * 8 + wave) * 16) * 512 + lane * 8;
#pragma unroll
            for (int ai = 0; ai < 2; ++ai)
#pragma unroll
                for (int m = 0; m < 4; ++m)
#pragma unroll
                    for (int bj = 0; bj < 2; ++bj) { const f32x4 v0 = acc[ai][bj][m][0], v1 = acc[ai][bj][m][1];
                        u32x4 w; w.x = cvt_pk_bf16(fsigmoid(v0[0]), fsigmoid(v0[1])); w.y = cvt_pk_bf16(fsigmoid(v0[2]), fsigmoid(v0[3])); w.z = cvt_pk_bf16(fsigmoid(v1[0]), fsigmoid(v1[1])); w.w = cvt_pk_bf16(fsigmoid(v1[2]), fsigmoid(v1[3]));
                        *(u32x4*)(gp + ((ai * 4 + m) * 2 + bj) * 512) = w; }
        }
    }
};
struct EpiGate {
    static constexpr bool PERM = true, AFTER_DRAIN = false;
    bf16_t* O; bf16_t* TW; const bf16_t* TR; const bf16_t* gate; int ldc;
    __device__ __forceinline__ void operator()(const f32x4 (&acc)[2][2][4][2], const Unit& u, int wr, int wc, int fr, int fq) const {
        const int row0 = u.pm * BM + wr * 64 + fr, col0 = u.pn * BM + wc * 32 + 8 * fq, wave = wr * 4 + wc, lane = fr + 16 * fq;
        const size_t rbase = ((size_t)((u.pm * 4 + u.pn) * 8 + wave) * 16) * 512 + lane * 8;
#pragma unroll
        for (int ai = 0; ai < 2; ++ai)
#pragma unroll
            for (int m = 0; m < 4; ++m) { const size_t r = (size_t)(row0 + ai * HALF + m * 16);
#pragma unroll
                for (int bj = 0; bj < 2; ++bj) { const f32x4 v0 = acc[ai][bj][m][0], v1 = acc[ai][bj][m][1]; const size_t ro = rbase + ((ai * 4 + m) * 2 + bj) * 512;
                    const u32x4 g = *(const u32x4*)(gate + ro);
                    float o[8];
                    o[0] = bf_lo(g.x) * v0[0]; o[1] = bf_hi(g.x) * v0[1]; o[2] = bf_lo(g.y) * v0[2]; o[3] = bf_hi(g.y) * v0[3];
                    o[4] = bf_lo(g.z) * v1[0]; o[5] = bf_hi(g.z) * v1[1]; o[6] = bf_lo(g.w) * v1[2]; o[7] = bf_hi(g.w) * v1[3];
                    if (TR) { const u32x4 t = *(const u32x4*)(TR + ro);
                        o[0] += bf_lo(t.x); o[1] += bf_hi(t.x); o[2] += bf_lo(t.y); o[3] += bf_hi(t.y); o[4] += bf_lo(t.z); o[5] += bf_hi(t.z); o[6] += bf_lo(t.w); o[7] += bf_hi(t.w); }
                    u32x4 w; w.x = cvt_pk_bf16(o[0], o[1]); w.y = cvt_pk_bf16(o[2], o[3]); w.z = cvt_pk_bf16(o[4], o[5]); w.w = cvt_pk_bf16(o[6], o[7]);
                    if (TW) *(u32x4*)(TW + ro) = w; else *(u32x4*)(O + r * ldc + col0 + bj * HALF) = w; } }
    }
};
struct EpiResid {
    static constexpr bool PERM = false, AFTER_DRAIN = false;
    const float* Xin; float* Xout; const float* gbias; const float* gpart; size_t part_stride;
    __device__ __forceinline__ void operator()(const f32x4 (&acc)[2][2][4][2], const Unit& u, int wr, int wc, int fr, int fq) const {
        const int row0 = u.pm * BM + wr * 64 + fr, col0 = u.pn * BM + wc * 32 + 4 * fq; const int b = u.pm >> 3;
        f32x4 gv[2][2];
#pragma unroll
        for (int bj = 0; bj < 2; ++bj)
#pragma unroll
            for (int n = 0; n < 2; ++n) { const int c = col0 + bj * HALF + n * 16; f32x4 g = *(const f32x4*)(gbias + c);
#pragma unroll
                for (int q = 0; q < 4; ++q) g += *(const f32x4*)(gpart + q * part_stride + (size_t)b * 6144 + c);
                gv[bj][n] = g; }
#pragma unroll
        for (int ai = 0; ai < 2; ++ai)
#pragma unroll
            for (int m = 0; m < 4; ++m) { const size_t off = (size_t)(row0 + ai * HALF + m * 16) * 1024 + col0;
#pragma unroll
                for (int bj = 0; bj < 2; ++bj)
#pragma unroll
                    for (int n = 0; n < 2; ++n) { const f32x4 xi = *(const f32x4*)(Xin + off + bj * HALF + n * 16);
                        *(f32x4*)(Xout + off + bj * HALF + n * 16) = xi + gv[bj][n] * acc[ai][bj][m][n]; } }
    }
};
struct EpiDelta {
    static constexpr bool PERM = true, AFTER_DRAIN = false;
    bf16_t* Dl; const float* gbias; const float* gpart; size_t part_stride;
    __device__ __forceinline__ void operator()(const f32x4 (&acc)[2][2][4][2], const Unit& u, int wr, int wc, int fr, int fq) const {
        const int row0 = u.pm * BM + wr * 64 + fr, col0 = u.pn * BM + wc * 32 + 8 * fq; const int b = u.pm >> 3;
        f32x4 gv[2][2];
#pragma unroll
        for (int bj = 0; bj < 2; ++bj)
#pragma unroll
            for (int n = 0; n < 2; ++n) { const int c = col0 + bj * HALF + 4 * n; f32x4 g = *(const f32x4*)(gbias + c);
#pragma unroll
                for (int q = 0; q < 4; ++q) g += *(const f32x4*)(gpart + q * part_stride + (size_t)b * 6144 + c);
                gv[bj][n] = g; }
#pragma unroll
        for (int ai = 0; ai < 2; ++ai)
#pragma unroll
            for (int m = 0; m < 4; ++m) { bf16_t* rowp = Dl + (size_t)(row0 + ai * HALF + m * 16) * 1024 + col0;
#pragma unroll
                for (int bj = 0; bj < 2; ++bj) { const f32x4 v0 = acc[ai][bj][m][0] * gv[bj][0], v1 = acc[ai][bj][m][1] * gv[bj][1];
                    u32x4 w; w.x = cvt_pk_bf16(v0[0], v0[1]); w.y = cvt_pk_bf16(v0[2], v0[3]); w.z = cvt_pk_bf16(v1[0], v1[1]); w.w = cvt_pk_bf16(v1[2], v1[3]);
                    *(u32x4*)(rowp + bj * HALF) = w; } }
    }
};
struct EpiSwiglu {
    static constexpr bool PERM = true, AFTER_DRAIN = false;
    bf16_t* U; int ldc; int pn_mod;
    __device__ __forceinline__ void operator()(const f32x4 (&acc)[2][2][4][2], const Unit& u, int wr, int wc, int fr, int fq) const {
        const int row0 = u.pm * BM + wr * 64 + fr, col0 = (u.pn % pn_mod) * HALF + wc * 32 + 8 * fq;
#pragma unroll
        for (int ai = 0; ai < 2; ++ai)
#pragma unroll
            for (int m = 0; m < 4; ++m) { bf16_t* rowp = U + (size_t)(row0 + ai * HALF + m * 16) * ldc + col0;
                const f32x4 g0 = acc[ai][0][m][0], g1 = acc[ai][0][m][1], u0 = acc[ai][1][m][0], u1 = acc[ai][1][m][1];
                u32x4 w; w.x = cvt_pk_bf16(fsilu(g0[0]) * u0[0], fsilu(g0[1]) * u0[1]); w.y = cvt_pk_bf16(fsilu(g0[2]) * u0[2], fsilu(g0[3]) * u0[3]);
                w.z = cvt_pk_bf16(fsilu(g1[0]) * u1[0], fsilu(g1[1]) * u1[1]); w.w = cvt_pk_bf16(fsilu(g1[2]) * u1[2], fsilu(g1[3]) * u1[3]);
                *(u32x4*)rowp = w; }
    }
};
struct MoeOrder : StaticOrder {
    const int* tile_e; int nNloc;
    __device__ void init_moe(int nT, int nN_, int G_, int c_, const int* te) { nM = nT; nN = nN_; nwg = nM * nN; G = G_; c = c_; tile_e = te; nNloc = nN_; }
    __device__ bool next(int i, Unit& u) const {
        if (!StaticOrder::next(i, u)) return false;
        const int e = __builtin_amdgcn_readfirstlane(tile_e[u.pm]); u.pn += e * nNloc; return true;
    }
};
template <class Epi, class Sched, bool ALIGN_EPI = false, bool SP2 = false>
__device__ __forceinline__ void gemm_phase(PG8_LAS unsigned char* lds, const Gemm g, const Sched& S, const Epi& E) {
    int tid_ = threadIdx.x; asm volatile("" : "+v"(tid_));
    const int tid = tid_, wid = __builtin_amdgcn_readfirstlane(tid >> 6), lane = tid & 63, wr = wid >> 2, wc = wid & 3, fr = lane & 15, fq = lane >> 4;
    const int K = g.K, nt = K / BK;
    unsigned voffA[2], voffB[2];
#pragma unroll
    for (int i = 0; i < 2; ++i) { int R, C; stage_rc(tid * 16 + i * 8192, R, C); const int Rb = Epi::PERM ? ((R & ~31) + perm32(R & 31)) : R;
        voffA[i] = (unsigned)(R * K + C) * 2u; voffB[i] = (unsigned)(Rb * K + C) * 2u; }
    const size_t kstep = (size_t)(BK * 2);
    const size_t hstep = (size_t)HALF * K * 2;
    const size_t tstep = 2 * hstep;
    const unsigned ldsw = (unsigned)wid * 1024u;
    const int aoff = lds_byte(wr * 64 + fr, fq * 8), boff = lds_byte(wc * 32 + fr, fq * 8);
#define PG8_SA(b, h) (((b) * 2 + (h)) * HTB)
#define PG8_SB(b, h) ((4 + (b) * 2 + (h)) * HTB)
#define PG8_STAGE(bufoff, gbase, voff) do { _Pragma("unroll") for (int _i = 0; _i < 2; ++_i) \
        __builtin_amdgcn_global_load_lds((const unsigned*)((const char*)(gbase) + (voff)[_i]), (PG8_LAS unsigned*)(lds + (bufoff) + ldsw + _i * 8192), 16, 0, 0); } while (0)
#define PG8_LDA(dst, b, h) do { _Pragma("unroll") for (int m = 0; m < 4; ++m) _Pragma("unroll") for (int k = 0; k < 2; ++k) dst[m][k] = *(const PG8_LAS bf16x8*)(lds + PG8_SA(b, h) + aoff + m * 2048 + k * 1024); } while (0)
#define PG8_LDB(dst, b, h) do { _Pragma("unroll") for (int n = 0; n < 2; ++n) _Pragma("unroll") for (int k = 0; k < 2; ++k) dst[n][k] = *(const PG8_LAS bf16x8*)(lds + PG8_SB(b, h) + boff + n * 2048 + k * 1024); } while (0)
#define PG8_MMA(ai, bj, At, Bt) do { __builtin_amdgcn_s_setprio(1); _Pragma("unroll") for (int m = 0; m < 4; ++m) _Pragma("unroll") for (int n = 0; n < 2; ++n) _Pragma("unroll") for (int k = 0; k < 2; ++k) \
        acc[ai][bj][m][n] = __builtin_amdgcn_mfma_f32_16x16x32_bf16(Bt[n][k], At[m][k], acc[ai][bj][m][n], 0, 0, 0); __builtin_amdgcn_s_setprio(0); } while (0)
#define PG8_WAIT_V(n) asm volatile("s_waitcnt vmcnt(" #n ")" ::: "memory")
#define PG8_WAIT_L(n) asm volatile("s_waitcnt lgkmcnt(" #n ")" ::: "memory")
#define PG8_BAR __builtin_amdgcn_s_barrier()
#define PG8_SCHED __builtin_amdgcn_sched_barrier(0)
    Unit cur, nxt; int ui = 0;
    if (!S.next(0, cur)) return;
    f32x4 acc[2][2][4][2];
#pragma unroll
    for (int a = 0; a < 2; ++a)
#pragma unroll
        for (int b = 0; b < 2; ++b)
#pragma unroll
            for (int m = 0; m < 4; ++m)
#pragma unroll
                for (int n = 0; n < 2; ++n) acc[a][b][m][n] = (f32x4){0.f, 0.f, 0.f, 0.f};
    bf16x8 At[4][2], B0[2][2], B1[2][2];
    const char* cA = (const char*)g.A + (size_t)cur.pm * tstep; const char* cB = (const char*)g.Bt + (size_t)cur.pn * tstep;
    S.a_ready(cur);
    if constexpr (SP2) {
        PG8_STAGE(PG8_SB(0, 0), cB, voffB); PG8_STAGE(PG8_SB(0, 1), cB + hstep, voffB); PG8_STAGE(PG8_SA(0, 0), cA, voffA); PG8_STAGE(PG8_SA(0, 1), cA + hstep, voffA);
        if (wr == 1) PG8_BAR;
        PG8_WAIT_V(2); PG8_BAR;
        PG8_STAGE(PG8_SB(1, 0), cB + kstep, voffB); PG8_STAGE(PG8_SA(1, 0), cA + kstep, voffA); PG8_STAGE(PG8_SB(1, 1), cB + hstep + kstep, voffB);
        PG8_WAIT_V(6); PG8_BAR;
    } else {
        PG8_STAGE(PG8_SB(0, 0), cB, voffB); PG8_STAGE(PG8_SA(0, 0), cA, voffA); PG8_STAGE(PG8_SB(0, 1), cB + hstep, voffB); PG8_STAGE(PG8_SA(0, 1), cA + hstep, voffA);
        if (wr == 1) PG8_BAR;
        PG8_WAIT_V(4); PG8_BAR;
        PG8_STAGE(PG8_SB(1, 0), cB + kstep, voffB); PG8_STAGE(PG8_SA(1, 0), cA + kstep, voffA); PG8_STAGE(PG8_SB(1, 1), cB + hstep + kstep, voffB);
        PG8_WAIT_V(6); PG8_BAR;
    }
    for (;;) {
        const bool has_next = S.next(ui + 1, nxt);
        const char* nA = has_next ? (const char*)g.A + (size_t)nxt.pm * tstep : cA; const char* nB = has_next ? (const char*)g.Bt + (size_t)nxt.pn * tstep : cB;
        for (int t = 0; t < nt; t += 2) {
            const bool last = (t == nt - 2);
            const char* a1 = cA + (size_t)(t + 1) * kstep;
            const char* a2 = last ? nA : cA + (size_t)(t + 2) * kstep; const char* b2 = last ? nB : cB + (size_t)(t + 2) * kstep;
            const char* a3 = a2 + kstep; const char* b3 = b2 + kstep;
            if (last && has_next) S.a_ready(nxt);
            if constexpr (SP2) {
            PG8_LDB(B0, 0, 0); PG8_LDB(B1, 0, 1); PG8_SCHED; PG8_LDA(At, 0, 0); PG8_STAGE(PG8_SA(1, 1), a1 + hstep, voffA);
            PG8_WAIT_V(8); PG8_WAIT_L(0); PG8_BAR; PG8_MMA(0, 0, At, B0); PG8_MMA(0, 1, At, B1); PG8_BAR; PG8_SCHED;
            PG8_LDA(At, 0, 1); PG8_STAGE(PG8_SB(0, 0), b2, voffB); PG8_STAGE(PG8_SB(0, 1), b2 + hstep, voffB); PG8_STAGE(PG8_SA(0, 0), a2, voffA);
            PG8_WAIT_V(8); PG8_WAIT_L(0); PG8_BAR; PG8_MMA(1, 0, At, B0); PG8_MMA(1, 1, At, B1); PG8_BAR; PG8_SCHED;
            PG8_LDB(B0, 1, 0); PG8_LDB(B1, 1, 1); PG8_SCHED; PG8_LDA(At, 1, 0); PG8_STAGE(PG8_SA(0, 1), a2 + hstep, voffA);
            PG8_WAIT_V(8); PG8_WAIT_L(0); PG8_BAR; PG8_MMA(0, 0, At, B0); PG8_MMA(0, 1, At, B1); PG8_BAR; PG8_SCHED;
            PG8_LDA(At, 1, 1); PG8_STAGE(PG8_SB(1, 0), b3, voffB); PG8_STAGE(PG8_SB(1, 1), b3 + hstep, voffB); PG8_STAGE(PG8_SA(1, 0), a3, voffA);
            PG8_WAIT_V(8); PG8_WAIT_L(0); PG8_BAR; PG8_MMA(1, 0, At, B0); PG8_MMA(1, 1, At, B1); PG8_BAR; PG8_SCHED;
            } else {
            PG8_LDB(B0, 0, 0); PG8_SCHED; PG8_LDA(At, 0, 0); PG8_STAGE(PG8_SA(1, 1), a1 + hstep, voffA);
            PG8_WAIT_L(8); PG8_BAR; PG8_WAIT_L(0); PG8_MMA(0, 0, At, B0); PG8_BAR; PG8_SCHED;
            PG8_LDB(B1, 0, 1); PG8_STAGE(PG8_SB(0, 0), b2, voffB);
            PG8_BAR; PG8_WAIT_L(0); PG8_MMA(0, 1, At, B1); PG8_BAR;
            PG8_LDA(At, 0, 1); PG8_STAGE(PG8_SA(0, 0), a2, voffA);
            PG8_BAR; PG8_WAIT_L(0); PG8_MMA(1, 0, At, B0); PG8_BAR; PG8_SCHED;
            PG8_STAGE(PG8_SB(0, 1), b2 + hstep, voffB);
            PG8_WAIT_V(6); PG8_BAR; PG8_MMA(1, 1, At, B1); PG8_BAR;
            PG8_LDB(B0, 1, 0); PG8_SCHED; PG8_LDA(At, 1, 0); PG8_STAGE(PG8_SA(0, 1), a2 + hstep, voffA);
            PG8_WAIT_L(8); PG8_BAR; PG8_WAIT_L(0); PG8_MMA(0, 0, At, B0); PG8_BAR; PG8_SCHED;
            PG8_LDB(B1, 1, 1); PG8_STAGE(PG8_SB(1, 0), b3, voffB);
            PG8_BAR; PG8_WAIT_L(0); PG8_MMA(0, 1, At, B1); PG8_BAR;
            PG8_LDA(At, 1, 1); PG8_STAGE(PG8_SA(1, 0), a3, voffA);
            PG8_BAR; PG8_WAIT_L(0); PG8_MMA(1, 0, At, B0); PG8_BAR; PG8_SCHED;
            PG8_STAGE(PG8_SB(1, 1), b3 + hstep, voffB);
            PG8_WAIT_V(6); PG8_BAR; PG8_MMA(1, 1, At, B1); PG8_BAR;
            }
        }
        if constexpr (ALIGN_EPI) { if (wr == 0) PG8_BAR; }
        if constexpr (!Epi::AFTER_DRAIN) { E(acc, cur, wr, wc, fr, fq); S.done(cur); }
        if (!has_next) break;
#pragma unroll
        for (int a = 0; a < 2; ++a)
#pragma unroll
            for (int b = 0; b < 2; ++b)
#pragma unroll
                for (int m = 0; m < 4; ++m)
#pragma unroll
                    for (int n = 0; n < 2; ++n) acc[a][b][m][n] = (f32x4){0.f, 0.f, 0.f, 0.f};
        cur = nxt; cA = nA; cB = nB; ++ui;
        if constexpr (ALIGN_EPI) { if (wr == 1) PG8_BAR; }
    }
    PG8_WAIT_V(0);
    if constexpr (!ALIGN_EPI) { if (wr == 0) PG8_BAR; }
    PG8_BAR;
    if constexpr (Epi::AFTER_DRAIN) { E.fused(acc, cur, wr, wc, fr, fq, lds, wid, lane); S.done(cur); }
#undef PG8_SA
#undef PG8_SB
#undef PG8_STAGE
#undef PG8_LDA
#undef PG8_LDB
#undef PG8_MMA
#undef PG8_WAIT_V
#undef PG8_WAIT_L
#undef PG8_BAR
#undef PG8_SCHED
}
}

constexpr int NWAVES = 8;
constexpr int D = 1024, BATCH = 16, SEQ = 2048, M = BATCH * SEQ, DEPTH = 4;
constexpr int NIN = 6928, NPW = 7168, NP = 5120;
constexpr int PC_Q = 0, PC_K = 512, PC_V = 1024, PC_G = 2048, PC_R = 3072, PC_RK = 3584, PC_RV = 4096, PC_PA = 4608, PC_WD = 4640, PC_AD = 4704, PC_GD = 4768, PC_GA = 5120, PC_GB = 6144;
constexpr int FFN = 2816, MFF = 3584, NEXP = 8;
constexpr int MOE_ROWS = 2 * M + NEXP * 256;
constexpr float NORM_EPS = 1e-6f;

constexpr size_t MiB = 1u << 20;
constexpr size_t WS_CTL = 0, CTL_ZERO_BYTES = 64 * 1024;
constexpr size_t WS_W2T = 1 * MiB, WS_A2T = WS_W2T + 65536, WS_G2T = WS_A2T + 65536;
constexpr size_t WS_MODP = 2 * MiB;
constexpr size_t WS_WIN = 8 * MiB, WS_GLAO = 22 * MiB, WS_RWO = 24 * MiB, WS_WOUT = 25 * MiB, WS_WFF = 27 * MiB;
constexpr size_t WS_FUP = WS_WFF, WS_FDN = WS_WFF + 11 * MiB, WS_MUP = WS_WFF, WS_MDN = WS_WFF + 112 * MiB;
constexpr size_t WS_H = 196 * MiB;
constexpr size_t WS_P = 260 * MiB;
constexpr size_t WS_GATE = 580 * MiB;
constexpr size_t WS_GO = 708 * MiB;
constexpr size_t WS_MG = 772 * MiB;
constexpr size_t WS_RG = 900 * MiB, WS_RV = 936 * MiB, WS_RY = 968 * MiB;
constexpr size_t WS_BC = 1028 * MiB;
constexpr size_t WS_MOE = 1029 * MiB;
constexpr size_t WS_ATT = 1095 * MiB;
constexpr size_t WS_DL = 1111 * MiB;
constexpr size_t WS_END = 1112 * MiB;
constexpr size_t WS_P1T = 772 * MiB, WS_Q1T = 804 * MiB, WS_BKT = 836 * MiB, WS_WC = 932 * MiB;
constexpr size_t WS_VTR = 1031 * MiB, WS_ULT = 1063 * MiB;
constexpr size_t WS_QE = WS_H, WS_KDT = WS_H + 32 * MiB;
constexpr size_t WS_U = WS_P;
constexpr size_t WS_HA = 722 * MiB;
static_assert(WS_U + (size_t)MOE_ROWS * MFF * 2 <= WS_HA && WS_HA + (size_t)MOE_ROWS * D * 2 <= WS_BC, "moe overlay");
constexpr size_t MO_TOPI = 0, MO_TOPW = 256 * 1024, MO_POS = 512 * 1024, MO_CNT = 768 * 1024, MO_TILE = 800 * 1024, MO_NT = 832 * 1024;
constexpr int CW_BAR = 4096;

constexpr int RING_OFF = 0, RING_BYTES = 131072;
constexpr int LDSCTL_OFF = 146432, MISC_OFF = LDSCTL_OFF + 320;
constexpr int LDS_BYTES = 147456;
static_assert(MISC_OFF + 128 <= LDS_BYTES, "LDS map");

#define GAS __attribute__((address_space(1)))
#define LAS __attribute__((address_space(3)))
typedef unsigned short bf16;
typedef unsigned v4u __attribute__((ext_vector_type(4)));
typedef unsigned v2u __attribute__((ext_vector_type(2)));
typedef float f32x4 __attribute__((ext_vector_type(4)));
#define LDS_WAIT() asm volatile("s_waitcnt lgkmcnt(0)" ::: "memory")
#define VM_WAIT() asm volatile("s_waitcnt vmcnt(0)" ::: "memory")
__device__ __forceinline__ unsigned f2bf(float f) { unsigned u = __builtin_bit_cast(unsigned, f); return (u + 0x7fffu + ((u >> 16) & 1u)) >> 16; }
__device__ __forceinline__ unsigned pk2(float lo, float hi) { return f2bf(lo) | (f2bf(hi) << 16); }
__device__ __forceinline__ float bf2f(bf16 b) { return __uint_as_float(((unsigned)b) << 16); }
__device__ __forceinline__ float blo(unsigned w) { return __uint_as_float(w << 16); }
__device__ __forceinline__ float bhi(unsigned w) { return __uint_as_float(w & 0xffff0000u); }
__device__ __forceinline__ float fexp_(float x) { return __builtin_amdgcn_exp2f(1.4426950408889634f * x); }
__device__ __forceinline__ float sigmoidf_(float x) { return __builtin_amdgcn_rcpf(1.0f + fexp_(-x)); }
__device__ __forceinline__ float softplusf_(float x) { return fmaxf(x, 0.f) + 0.6931471805599453f * __builtin_amdgcn_logf(1.0f + fexp_(-fabsf(x))); }
__device__ __forceinline__ float tanhf_(float x) { return 1.0f - 2.0f * __builtin_amdgcn_rcpf(1.0f + fexp_(2.0f * x)); }
template <int CTRL, int RMASK> __device__ __forceinline__ float dppadd_(float x) { return x + __builtin_bit_cast(float, __builtin_amdgcn_update_dpp(0, __builtin_bit_cast(int, x), CTRL, RMASK, 0xf, false)); }
__device__ __forceinline__ float rowsum16(float x) { x = dppadd_<0x128, 0xf>(x); x = dppadd_<0x124, 0xf>(x); x = dppadd_<0x122, 0xf>(x); x = dppadd_<0x121, 0xf>(x); return x; }
__device__ __forceinline__ float sum8(float x) { x = dppadd_<0xB1, 0xf>(x); x = dppadd_<0x4E, 0xf>(x); x = dppadd_<0x141, 0xf>(x); return x; }
__device__ __forceinline__ float wave_sum(float v) {
    v = rowsum16(v);
    v = dppadd_<0x142, 0xa>(v);
    v = dppadd_<0x143, 0xc>(v);
    return __builtin_bit_cast(float, __builtin_amdgcn_readlane(__builtin_bit_cast(int, v), 63));
}

struct Args { const float* in[32]; float* out; unsigned char* ws; int l_lo, l_hi, ph_lo, ph_hi, fused, pad; };
#define XB_TMO      128
#define XB_XCNT(j)  (256  + 64 * (j))
#define XB_XSUB(j)  (1280 + 64 * (j))
#define XB_XGEN(j)  (2304 + 64 * (j))
#define XB_TOP      3328
#define XB_TOPGEN   3392
#define XCD_BAR_WORDS 3456
#define XB_SPIN_CAP (1u << 18)

__device__ __forceinline__ unsigned xb_ld(unsigned* p)              { return __hip_atomic_load(p, __ATOMIC_RELAXED, __HIP_MEMORY_SCOPE_AGENT); }
__device__ __forceinline__ unsigned xb_add(unsigned* p, unsigned v) { return __hip_atomic_fetch_add(p, v, __ATOMIC_RELAXED, __HIP_MEMORY_SCOPE_AGENT); }
__device__ __forceinline__ unsigned xb_xcc_id() { return (unsigned)__builtin_amdgcn_s_getreg((3 << 11) | 20) & 0xFu; }
#define XB_SPIN(cond, bar) do { unsigned _sp = 0; while (cond) { __builtin_amdgcn_s_sleep(1); \
    if ((++_sp & 255u) == 0u) { if (xb_ld(&(bar)[XB_TMO])) break; if (_sp > XB_SPIN_CAP) { atomicAdd(&(bar)[XB_TMO], 1u); break; } } } } while (0)

struct XcdBarrier {
    unsigned* bar; unsigned x;
    volatile LAS unsigned* st;
};

__device__ __forceinline__ XcdBarrier xcd_barrier_post(unsigned* bar, volatile LAS unsigned* st) {
    XcdBarrier b; b.bar = bar; b.x = xb_xcc_id(); b.st = st;
    if (threadIdx.x == 0) (void)xb_add(&bar[XB_XCNT(b.x)], 1u);
    return b;
}
__device__ __forceinline__ void xcd_barrier_complete(unsigned* bar, unsigned x, unsigned& nloc, unsigned& nx) {
    const unsigned G = gridDim.x * gridDim.y * gridDim.z;
    unsigned sum, cnt, mine, sp = 0u;
    for (;;) {
        sum = 0u; cnt = 0u; mine = 0u;
#pragma unroll
        for (unsigned j = 0; j < 16; ++j) { const unsigned c = xb_ld(&bar[XB_XCNT(j)]); sum += c; cnt += (c > 0u) ? 1u : 0u; mine = (j == x) ? c : mine; }
        if (sum == G) break;
        __builtin_amdgcn_s_sleep(1);
        if ((++sp & 255u) == 0u) { if (xb_ld(&bar[XB_TMO])) break; if (sp > XB_SPIN_CAP) { atomicAdd(&bar[XB_TMO], 1u); break; } }
    }
    nloc = mine > 0u ? mine : 1u; nx = cnt > 0u ? cnt : 1u;
}

__device__ __forceinline__ void xcd_barrier(const XcdBarrier& b) {
    asm volatile("s_waitcnt vmcnt(0)" ::: "memory");
    __syncthreads();
    if (threadIdx.x == 0) {
        unsigned* bar = b.bar;
        __builtin_amdgcn_s_waitcnt(0);
        unsigned nloc = b.st[0], nx = b.st[1];
        if (nloc == 0u) { xcd_barrier_complete(bar, b.x, nloc, nx); b.st[0] = nloc; b.st[1] = nx; }
        const unsigned old = xb_add(&bar[XB_XSUB(b.x)], 1u);
        const unsigned gen = old / nloc;
        if (old + 1u == (gen + 1u) * nloc) {
            __builtin_amdgcn_fence(__ATOMIC_RELEASE, "agent");
            asm volatile("s_waitcnt vmcnt(0)" ::: "memory");
            const unsigned og = xb_add(&bar[XB_TOP], 1u);
            const unsigned tg = og / nx;
            if (og + 1u == (tg + 1u) * nx) xb_add(&bar[XB_TOPGEN], 1u);
            else XB_SPIN(xb_ld(&bar[XB_TOPGEN]) == tg, bar);
            __builtin_amdgcn_fence(__ATOMIC_ACQUIRE, "agent");
            xb_add(&bar[XB_XGEN(b.x)], 1u);
            asm volatile("s_waitcnt vmcnt(0)" ::: "memory");
        } else {
            XB_SPIN(xb_ld(&bar[XB_XGEN(b.x)]) == gen, bar);
            __builtin_amdgcn_fence(__ATOMIC_ACQUIRE, "agent");
            asm volatile("s_waitcnt vmcnt(0)" ::: "memory");
        }
    }
    __syncthreads();
}

struct Frame {
    LAS unsigned char* lds;
    volatile LAS unsigned* MISC;
    int tid, lane, wave, vcu, G;
    float* out; unsigned char* ws;
};
#define WSP(T, off) ((T*)(F.ws + (off)))

__device__ __forceinline__ f32x4 mod4(const Frame& F, const Args& A, int l, int b, int j) {
    f32x4 v = *(const f32x4*)(A.in[3] + (size_t)l * 6144 + j);
    const float* mp = WSP(const float, WS_MODP);
#pragma unroll
    for (int q = 0; q < 4; ++q) v += *(const f32x4*)(mp + ((size_t)((q * 4 + l) * 16 + b)) * 6144 + j);
    return v;
}

__device__ __forceinline__ void phase_mod(Frame& F, const Args& A) {
    if (blockIdx.x < 192) {
        LAS float* sC = (LAS float*)F.lds;
        const int idx = blockIdx.x * 512 + F.tid, j = idx % 6144, ql = idx / 6144, l = ql & 3, q = ql >> 2;
        const float* c = A.in[1];
        for (int i = F.tid; i < 16 * 256; i += 512) { const int b = i >> 8, k = i & 255; const float cv = c[b * 1024 + q * 256 + k]; sC[i] = cv * sigmoidf_(cv); }
        __syncthreads();
        float acc[16];
#pragma unroll
        for (int b = 0; b < 16; ++b) acc[b] = 0.f;
        const float* wp = A.in[2] + ((size_t)l * 1024 + q * 256) * 6144 + j;
        for (int k0 = 0; k0 < 256; k0 += 16) { float wv[16];
#pragma unroll
            for (int kk = 0; kk < 16; ++kk) wv[kk] = wp[(size_t)(k0 + kk) * 6144];
#pragma unroll
            for (int kk = 0; kk < 16; ++kk)
#pragma unroll
                for (int b = 0; b < 16; ++b) acc[b] += sC[b * 256 + k0 + kk] * wv[kk]; }
        float* mp = WSP(float, WS_MODP);
#pragma unroll
        for (int b = 0; b < 16; ++b) mp[((size_t)((q * 4 + l) * 16 + b)) * 6144 + j] = acc[b];
    }
    __syncthreads();
}

__device__ __forceinline__ void transpose_item(const float* src, int ldsrc, int k0, int srccol, bf16* dst, int lddst, int drow0, LAS float* scr, int lane) {
    float tv[32];
#pragma unroll
    for (int i = 0; i < 32; ++i) { const int kk = 2 * i + (lane >> 5); tv[i] = srccol >= 0 ? src[(size_t)(k0 + kk) * ldsrc + srccol] : 0.f; }
#pragma unroll
    for (int i = 0; i < 32; ++i) { const int kk = 2 * i + (lane >> 5); scr[kk * 33 + (lane & 31)] = tv[i]; }
    LDS_WAIT(); asm volatile("" ::: "memory");
    const int c = lane & 7;
#pragma unroll
    for (int j = 0; j < 4; ++j) { const int n = (lane >> 3) + 8 * j; const LAS float* s = scr + (8 * c) * 33 + n;
        v4u o; o.x = pk2(s[0 * 33], s[1 * 33]); o.y = pk2(s[2 * 33], s[3 * 33]); o.z = pk2(s[4 * 33], s[5 * 33]); o.w = pk2(s[6 * 33], s[7 * 33]);
        *(v4u*)(dst + (size_t)(drow0 + n) * lddst + k0 + 8 * c) = o; }
    LDS_WAIT(); asm volatile("" ::: "memory");
}
__device__ __forceinline__ void transpose_item_lora(const float* src, int ldsrc, int k0, int srccol, bf16* dst, int fbase, int drow0, LAS float* scr, int lane) {
#pragma unroll 8
    for (int i = 0; i < 32; ++i) { const int kk = 2 * i + (lane >> 5); scr[kk * 33 + (lane & 31)] = src[(size_t)(k0 + kk) * ldsrc + srccol]; }
    LDS_WAIT(); asm volatile("" ::: "memory");
    const int c = lane & 7;
#pragma unroll
    for (int j = 0; j < 4; ++j) { const int n = (lane >> 3) + 8 * j; const LAS float* s = scr + (8 * c) * 33 + n;
        v4u o; o.x = pk2(s[0 * 33], s[1 * 33]); o.y = pk2(s[2 * 33], s[3 * 33]); o.z = pk2(s[4 * 33], s[5 * 33]); o.w = pk2(s[6 * 33], s[7 * 33]);
        const int ch = drow0 + n, k = k0 + 8 * c, f = fbase + (k >> 5), kq = (k & 31) >> 3;
        *(v4u*)(dst + ((size_t)((((ch >> 6) * 4 + ((ch >> 4) & 3)) * 8 + f) * 64) + (ch & 15) + 16 * kq) * 8) = o; }
    LDS_WAIT(); asm volatile("" ::: "memory");
}
__device__ __forceinline__ int win_srccol(int n) {
    if (n < 3072) return n;
    if (n < 3584) return 3088 + (n - 3072);
    if (n < 4096) return 3664 + (n - 3584);
    if (n < 4608) return 4176 + (n - 4096);
    if (n < 4624) return 3072 + (n - 4608);
    if (n < 4640) return -1;
    if (n < 4704) return 3600 + (n - 4640);
    if (n < 4768) return 4688 + (n - 4704);
    if (n < 4896) return 4752 + (n - 4768);
    if (n < 5120) return -1;
    if (n < 6144) return 4880 + (n - 5120);
    return 5904 + (n - 6144);
}
struct CItem { const float* sp; bf16* dp; int ldsrc, lddst, valid, lora, k0, drow0; };
__device__ __forceinline__ CItem conv_decode(Frame& F, const Args& A, int l, int it, int lane) {
    constexpr int I_LO = 16 + 16 + 32, I_IN = 16 * 224, I_GO = 16 * 32, I_RO = 8 * 32, I_WO = 16 * 32, I_FU = 16 * 176, I_MU = 8 * 16 * 224;
    const int l31 = lane & 31; const bool moe = (l & 1); const int li = l >> 1;
    CItem c; c.lora = -1; c.valid = 1; int r = it;
    const float* src; int srccol, kb, nb;
    if (r < I_LO) {
        if (r < 16) { src = A.in[13] + (size_t)l * 64 * 512; c.lora = 0; kb = 0; nb = r; }
        else if (r < 32) { src = A.in[15] + (size_t)l * 64 * 512; c.lora = 2; kb = 0; nb = r - 16; }
        else { src = A.in[16] + (size_t)l * 128 * 512; c.lora = 4; kb = (r - 32) >> 4; nb = (r - 32) & 15; }
        c.ldsrc = 512; srccol = nb * 32 + l31; c.dp = WSP(bf16, WS_W2T); c.lddst = 0; c.k0 = kb * 64; c.drow0 = nb * 32;
    } else if ((r -= I_LO) < I_IN) { kb = r / 224; nb = r % 224; src = A.in[6] + (size_t)l * 1024 * NIN; c.ldsrc = NIN; srccol = win_srccol(nb * 32 + l31); c.dp = WSP(bf16, WS_WIN); c.lddst = 1024; c.k0 = kb * 64; c.drow0 = nb * 32;
    } else if ((r -= I_IN) < I_GO) { kb = r / 32; nb = r % 32; src = A.in[10] + (size_t)l * 1024 * 1024; c.ldsrc = 1024; srccol = nb * 32 + l31; c.dp = WSP(bf16, WS_GLAO); c.lddst = 1024; c.k0 = kb * 64; c.drow0 = nb * 32;
    } else if ((r -= I_GO) < I_RO) { kb = r / 32; nb = r % 32; src = A.in[22] + (size_t)l * 512 * 1024; c.ldsrc = 1024; srccol = nb * 32 + l31; c.dp = WSP(bf16, WS_RWO); c.lddst = 512; c.k0 = kb * 64; c.drow0 = nb * 32;
    } else if ((r -= I_RO) < I_WO) { kb = r / 32; nb = r % 32; src = A.in[23] + (size_t)l * 1024 * 1024; c.ldsrc = 1024; srccol = nb * 32 + l31; c.dp = WSP(bf16, WS_WOUT); c.lddst = 1024; c.k0 = kb * 64; c.drow0 = nb * 32;
    } else { r -= I_WO;
        if (!moe) {
            if (r < I_FU) { kb = r / 176; nb = r % 176; const int n0 = nb * 32, pn = n0 >> 8, within = n0 & 255;
                src = (within < 128 ? A.in[24] : A.in[25]) + (size_t)li * 1024 * FFN; c.ldsrc = FFN; srccol = pn * 128 + (within & 127) + l31; c.dp = WSP(bf16, WS_FUP); c.lddst = 1024; c.k0 = kb * 64; c.drow0 = n0; }
            else { r -= I_FU; kb = r / 32; nb = r % 32; src = A.in[26] + (size_t)li * FFN * 1024; c.ldsrc = 1024; srccol = nb * 32 + l31; c.dp = WSP(bf16, WS_FDN); c.lddst = FFN; c.k0 = kb * 64; c.drow0 = nb * 32; }
        } else {
            if (r < I_MU) { const int e = r / (16 * 224), rr = r % (16 * 224); kb = rr / 224; nb = rr % 224; const int n0 = nb * 32, pn = n0 >> 8, within = n0 & 255;
                src = (within < 128 ? A.in[28] : A.in[29]) + ((size_t)(li * 8 + e)) * 1024 * MFF; c.ldsrc = MFF; srccol = pn * 128 + (within & 127) + l31; c.dp = WSP(bf16, WS_MUP) + (size_t)e * 7168 * 1024; c.lddst = 1024; c.k0 = kb * 64; c.drow0 = n0; }
            else { r -= I_MU; const int e = r / (56 * 32), rr = r % (56 * 32); kb = rr / 32; nb = rr % 32;
                src = A.in[30] + ((size_t)(li * 8 + e)) * MFF * 1024; c.ldsrc = 1024; srccol = nb * 32 + l31; c.dp = WSP(bf16, WS_MDN) + (size_t)e * 1024 * MFF; c.lddst = MFF; c.k0 = kb * 64; c.drow0 = nb * 32; }
        }
    }
    c.valid = srccol >= 0; c.sp = src + (size_t)c.k0 * c.ldsrc + (srccol >= 0 ? srccol : 0);
    return c;
}
__device__ __forceinline__ void conv_finish(const CItem& c, const float (&tv)[32], LAS float* scr, int lane) {
#pragma unroll
    for (int i = 0; i < 32; ++i) { const int kk = 2 * i + (lane >> 5); scr[kk * 33 + (lane & 31)] = tv[i]; }
    LDS_WAIT(); asm volatile("" ::: "memory");
    const int cc = lane & 7;
#pragma unroll
    for (int j = 0; j < 4; ++j) { const int n = (lane >> 3) + 8 * j; const LAS float* s = scr + (8 * cc) * 33 + n;
        v4u o; o.x = pk2(s[0 * 33], s[1 * 33]); o.y = pk2(s[2 * 33], s[3 * 33]); o.z = pk2(s[4 * 33], s[5 * 33]); o.w = pk2(s[6 * 33], s[7 * 33]);
        if (c.lora >= 0) { const int ch = c.drow0 + n, k = c.k0 + 8 * cc, f = c.lora + (k >> 5), kq = (k & 31) >> 3;
            *(v4u*)(c.dp + ((size_t)((((ch >> 6) * 4 + ((ch >> 4) & 3)) * 8 + f) * 64) + (ch & 15) + 16 * kq) * 8) = o; }
        else *(v4u*)(c.dp + (size_t)(c.drow0 + n) * c.lddst + c.k0 + 8 * cc) = o; }
    LDS_WAIT(); asm volatile("" ::: "memory");
}
__device__ __forceinline__ void phase_conv(Frame& F, const Args& A, int l) {
    LAS float* scr = (LAS float*)(F.lds + RING_OFF + F.wave * 16384);
    const int gw = F.vcu * NWAVES + F.wave, NGW = F.G * NWAVES, lane = F.lane;
    constexpr int I_LO = 16 + 16 + 32, I_IN = 16 * 224, I_GO = 16 * 32, I_RO = 8 * 32, I_WO = 16 * 32, I_FU = 16 * 176, I_FD = 44 * 32, I_MU = 8 * 16 * 224, I_MD = 8 * 56 * 32;
    const int nitems = I_LO + I_IN + I_GO + I_RO + I_WO + ((l & 1) ? (I_MU + I_MD) : (I_FU + I_FD));
    int it = gw; if (it >= nitems) return;
    CItem cur = conv_decode(F, A, l, it, lane); float tv[32];
#define CONV_LOAD(c_, t_) do { _Pragma("unroll") for (int i = 0; i < 32; ++i) { const int kk = 2 * i + (lane >> 5); (t_)[i] = (c_).valid ? (c_).sp[(size_t)kk * (c_).ldsrc] : 0.f; } } while (0)
    CONV_LOAD(cur, tv);
    for (;;) {
        const int nit = it + NGW; CItem nxt = cur; float tvn[32];
        if (nit < nitems) { nxt = conv_decode(F, A, l, nit, lane); CONV_LOAD(nxt, tvn); }
        conv_finish(cur, tv, scr, lane);
        if (nit >= nitems) break;
        cur = nxt; it = nit;
#pragma unroll
        for (int i = 0; i < 32; ++i) tv[i] = tvn[i];
    }
#undef CONV_LOAD
}

template <int WHICH>
__device__ __forceinline__ void phase_norm(Frame& F, const Args& A, int l, const float* xin, bool delta) {
    const int gw = F.vcu * NWAVES + F.wave, lane = F.lane, row0 = gw * 16, b = row0 >> 11;
    const float* gain = (WHICH == 0 ? A.in[4] : A.in[5]) + (size_t)l * 1024;
    const int jsh = (WHICH == 0 ? 0 : 3072), jsc = jsh + 1024;
    f32x4 g[4], sc[4], sh[4];
#pragma unroll
    for (int j = 0; j < 4; ++j) { const int c = 4 * lane + 256 * j; g[j] = *(const f32x4*)(gain + c); sc[j] = mod4(F, A, l, b, jsc + c) + 1.0f; sh[j] = mod4(F, A, l, b, jsh + c); g[j] = g[j] * sc[j]; }
    LAS float* sR = (LAS float*)F.lds;
    LAS int* sCnt = (LAS int*)(F.lds + 32768);
    if (WHICH == 2) {
        const float* rt = A.in[27] + (size_t)(l >> 1) * 1024 * 8;
        for (int i = F.tid; i < 8192; i += 512) sR[i] = rt[i];
        if (F.tid < 8) sCnt[F.tid] = 0;
        __syncthreads();
    }
    bf16* H = WSP(bf16, WS_H);
#pragma unroll 2
    for (int rr = 0; rr < 16; ++rr) {
        const int m = row0 + rr;
        f32x4 x[4]; float ss = 0.f;
#pragma unroll
        for (int j = 0; j < 4; ++j) { x[j] = *(const f32x4*)(xin + (size_t)m * 1024 + 4 * lane + 256 * j);
            if (delta) { const v2u dv = *(const v2u*)(H + (size_t)m * 1024 + 4 * lane + 256 * j); x[j].x += blo(dv.x); x[j].y += bhi(dv.x); x[j].z += blo(dv.y); x[j].w += bhi(dv.y);
                *(f32x4*)(F.out + (size_t)m * 1024 + 4 * lane + 256 * j) = x[j]; }
            ss += (x[j].x * x[j].x + x[j].y * x[j].y) + (x[j].z * x[j].z + x[j].w * x[j].w); }
        const float rs = __builtin_amdgcn_rsqf(wave_sum(ss) * (1.0f / 1024.0f) + NORM_EPS);
#pragma unroll
        for (int j = 0; j < 4; ++j) { x[j] = (x[j] * rs) * g[j] + sh[j];
            v2u o; o.x = pk2(x[j].x, x[j].y); o.y = pk2(x[j].z, x[j].w);
            *(v2u*)(H + (size_t)m * 1024 + 4 * lane + 256 * j) = o; }
        if (WHICH == 2) {
            float lg[8];
#pragma unroll
            for (int e = 0; e < 8; ++e) lg[e] = 0.f;
#pragma unroll
            for (int j = 0; j < 4; ++j)
#pragma unroll
                for (int i = 0; i < 4; ++i) { const int c = 4 * lane + 256 * j + i; const f32x4 r0 = *(const LAS f32x4*)(sR + c * 8), r1 = *(const LAS f32x4*)(sR + c * 8 + 4); const float xv = x[j][i];
                    lg[0] += xv * r0.x; lg[1] += xv * r0.y; lg[2] += xv * r0.z; lg[3] += xv * r0.w; lg[4] += xv * r1.x; lg[5] += xv * r1.y; lg[6] += xv * r1.z; lg[7] += xv * r1.w; }
#pragma unroll
            for (int e = 0; e < 8; ++e) lg[e] = wave_sum(lg[e]);
            if (lane == 0) {
                int i1 = 0; float v1 = lg[0];
#pragma unroll
                for (int e = 1; e < 8; ++e) if (lg[e] > v1) { v1 = lg[e]; i1 = e; }
                int i2 = (i1 + 1) & 7; float v2 = lg[i2];
#pragma unroll
                for (int e = 0; e < 8; ++e) if (e != i1 && (lg[e] > v2 || (lg[e] == v2 && e < i2))) { v2 = lg[e]; i2 = e; }
                const float w2 = 1.0f / (1.0f + fexp_(v1 - v2)), w1 = 1.0f - w2;
                int* topi = (int*)(F.ws + WS_MOE + MO_TOPI); float* topw = (float*)(F.ws + WS_MOE + MO_TOPW);
                topi[2 * m] = i1; topi[2 * m + 1] = i2; topw[2 * m] = w1; topw[2 * m + 1] = w2;
                atomicAdd((int*)&sCnt[i1], 1); atomicAdd((int*)&sCnt[i2], 1);
            }
        }
    }
    if (WHICH == 2) {
        __syncthreads();
        if (F.tid < 8) ((int*)(F.ws + WS_MOE + MO_CNT))[F.vcu * 8 + F.tid] = sCnt[F.tid];
        __syncthreads();
    }
}

__device__ __forceinline__ void phase_route2(Frame& F, const Args& A) {
    LAS int* sI = (LAS int*)F.lds;
    const int* cnt = (const int*)(F.ws + WS_MOE + MO_CNT);
    const int* topi = (const int*)(F.ws + WS_MOE + MO_TOPI);
    int* pos = (int*)(F.ws + WS_MOE + MO_POS);
    const int wgi = F.vcu, m0 = wgi * 128, lane = F.lane, e = F.wave;
    LAS int* sT = sI + 512;
    if (F.tid < 256) sT[F.tid] = topi[2 * m0 + F.tid];
    { int tot = 0, pre = 0;
#pragma unroll
      for (int j = 0; j < 4; ++j) { const int w = 4 * lane + j; const int c = cnt[w * 8 + e]; tot += c; pre += (w < wgi) ? c : 0; }
#pragma unroll
      for (int o = 1; o < 64; o <<= 1) { tot += __shfl_xor(tot, o); pre += __shfl_xor(pre, o); }
      if (lane == 0) { sI[e] = tot; sI[8 + e] = pre; } }
    __syncthreads();
    if (F.tid == 0) { int base = 0; for (int k = 0; k < 8; ++k) { sI[16 + k] = base; base += ((sI[k] + 255) >> 8) << 8; } sI[24] = base; }
    __syncthreads();
    { int run = sI[16 + e] + sI[8 + e];
#pragma unroll
      for (int k = 0; k < 4; ++k) { const bool hit = sT[k * 64 + lane] == e; const unsigned long long mk = __ballot(hit);
          const int rank = __popcll(mk & ((1ull << lane) - 1ull));
          if (hit) sI[32 + k * 64 + lane] = run + rank; run += __popcll(mk); } }
    __syncthreads();
    if (F.tid < 256) pos[2 * m0 + F.tid] = sI[32 + F.tid];
    if (wgi == 0 && F.tid >= 64 && F.tid < 64 + 264) {
        const int t = F.tid - 64; int ee = 0;
#pragma unroll
        for (int k = 1; k < 8; ++k) if (t * 256 >= sI[16 + k]) ee = k;
        ((int*)(F.ws + WS_MOE + MO_TILE))[t] = ee;
        if (t == 0) ((int*)(F.ws + WS_MOE + MO_NT))[0] = sI[24] >> 8;
    }
    const bf16* H = WSP(const bf16, WS_H); bf16* HA = WSP(bf16, WS_HA);
#pragma unroll
    for (int p0 = 0; p0 < 32; p0 += 16) { v4u ra[16], rb[16];
#pragma unroll
        for (int q = 0; q < 16; ++q) { const int p = F.wave * 32 + p0 + q, m = m0 + (p >> 1); ra[q] = *(const v4u*)(H + (size_t)m * 1024 + lane * 16); rb[q] = *(const v4u*)(H + (size_t)m * 1024 + lane * 16 + 8); }
#pragma unroll
        for (int q = 0; q < 16; ++q) { const int slot = sI[32 + F.wave * 32 + p0 + q]; *(v4u*)(HA + (size_t)slot * 1024 + lane * 16) = ra[q]; *(v4u*)(HA + (size_t)slot * 1024 + lane * 16 + 8) = rb[q]; } }
    if (wgi < 8) { const int lo = sI[16 + wgi] + sI[wgi], hi = sI[16 + wgi + 1];
        const v4u z = {0u, 0u, 0u, 0u};
        for (int r = lo + F.wave; r < hi; r += NWAVES) { *(v4u*)(HA + (size_t)r * 1024 + lane * 16) = z; *(v4u*)(HA + (size_t)r * 1024 + lane * 16 + 8) = z; } }
    __syncthreads();
}

__device__ __forceinline__ void phase_combine(Frame& F, const Args& A, int l, bool dry) {
    const int gw = F.vcu * NWAVES + F.wave, lane = F.lane, row0 = gw * 16, b = row0 >> 11;
    const bool last = (l == DEPTH - 1);
    f32x4 g2[4], ng[4], nsh[4];
#pragma unroll
    for (int j = 0; j < 4; ++j) { const int c = 4 * lane + 256 * j; g2[j] = mod4(F, A, l, b, 5120 + c);
        if (last) { ng[j] = *(const f32x4*)(A.in[31] + c); nsh[j] = (f32x4){0.f, 0.f, 0.f, 0.f}; }
        else { ng[j] = *(const f32x4*)(A.in[4] + (size_t)(l + 1) * 1024 + c) * (mod4(F, A, l + 1, b, 1024 + c) + 1.0f); nsh[j] = mod4(F, A, l + 1, b, c); } }
    const int* pos = (const int*)(F.ws + WS_MOE + MO_POS); const float* topw = (const float*)(F.ws + WS_MOE + MO_TOPW);
    const bf16* YP = WSP(const bf16, WS_HA); bf16* H = dry ? (bf16*)(F.ws + 1031 * MiB) : WSP(bf16, WS_H); float* xo = dry ? (float*)(F.ws + 27 * MiB) : F.out;
    const int myp = pos[2 * row0 + (lane & 31)]; const float myw = topw[2 * row0 + (lane & 31)];
#pragma unroll 4
    for (int rr = 0; rr < 16; ++rr) { const int m = row0 + rr; const int p1 = __shfl(myp, 2 * rr), p2 = __shfl(myp, 2 * rr + 1); const float w1 = __shfl(myw, 2 * rr), w2 = __shfl(myw, 2 * rr + 1);
        f32x4 x[4]; float ss = 0.f;
#pragma unroll
        for (int j = 0; j < 4; ++j) { const int c = 4 * lane + 256 * j; const v2u a = *(const v2u*)(YP + (size_t)p1 * 1024 + c), bb = *(const v2u*)(YP + (size_t)p2 * 1024 + c);
            f32x4 y; y.x = w1 * blo(a.x) + w2 * blo(bb.x); y.y = w1 * bhi(a.x) + w2 * bhi(bb.x); y.z = w1 * blo(a.y) + w2 * blo(bb.y); y.w = w1 * bhi(a.y) + w2 * bhi(bb.y);
            x[j] = *(const f32x4*)(F.out + (size_t)m * 1024 + c) + g2[j] * y; ss += (x[j].x * x[j].x + x[j].y * x[j].y) + (x[j].z * x[j].z + x[j].w * x[j].w); }
        const float rs = __builtin_amdgcn_rsqf(wave_sum(ss) * (1.0f / 1024.0f) + NORM_EPS);
#pragma unroll
        for (int j = 0; j < 4; ++j) { const int c = 4 * lane + 256 * j; float* xp = xo + (size_t)m * 1024 + c;
            const f32x4 hn = (x[j] * rs) * ng[j] + nsh[j];
            if (last) *(f32x4*)xp = hn;
            else { *(f32x4*)xp = x[j]; v2u o; o.x = pk2(hn.x, hn.y); o.y = pk2(hn.z, hn.w); *(v2u*)(H + (size_t)m * 1024 + c) = o; } } }
}

__device__ __forceinline__ void phase_final(Frame& F, const Args& A) {
    const int gw = F.vcu * NWAVES + F.wave, lane = F.lane, row0 = gw * 16;
    f32x4 g[4];
#pragma unroll
    for (int j = 0; j < 4; ++j) g[j] = *(const f32x4*)(A.in[31] + 4 * lane + 256 * j);
    for (int rr = 0; rr < 16; ++rr) { const int m = row0 + rr; f32x4 x[4]; float ss = 0.f;
#pragma unroll
        for (int j = 0; j < 4; ++j) { x[j] = *(const f32x4*)(F.out + (size_t)m * 1024 + 4 * lane + 256 * j); ss += (x[j].x * x[j].x + x[j].y * x[j].y) + (x[j].z * x[j].z + x[j].w * x[j].w); }
        const float rs = __builtin_amdgcn_rsqf(wave_sum(ss) * (1.0f / 1024.0f) + NORM_EPS);
#pragma unroll
        for (int j = 0; j < 4; ++j) *(f32x4*)(F.out + (size_t)m * 1024 + 4 * lane + 256 * j) = (x[j] * rs) * g[j]; }
}

__device__ __forceinline__ void phase_post(Frame& F, const Args& A, int l, bool dry) {
    const int gw = F.vcu * NWAVES + F.wave, lane = F.lane, row0 = gw * 16;
    const bf16* P = WSP(const bf16, WS_P); bf16* GO = WSP(bf16, WS_GO); bf16* RY = WSP(bf16, WS_RY);
    bf16* GOo = dry ? (bf16*)(F.ws + 772 * MiB) : GO; bf16* RYo = dry ? (bf16*)(F.ws + 836 * MiB) : RY;
    const bf16* RV = WSP(const bf16, WS_RV); const bf16* RG = WSP(const bf16, WS_RG); const float* BC = WSP(const float, WS_BC);
    float ng[16];
    { const float* p = A.in[9] + (size_t)l * 1024 + 16 * lane;
#pragma unroll
      for (int i = 0; i < 4; ++i) { const f32x4 v = *(const f32x4*)(p + 4 * i); ng[4 * i] = v.x; ng[4 * i + 1] = v.y; ng[4 * i + 2] = v.z; ng[4 * i + 3] = v.w; } }
    float lg[8], lb[8];
    { const float* p = A.in[20] + (size_t)l * 512 + 8 * lane; const float* q = A.in[21] + (size_t)l * 512 + 8 * lane;
#pragma unroll
      for (int i = 0; i < 8; ++i) { lg[i] = p[i]; lb[i] = q[i]; } }
#pragma unroll 2
    for (int rr = 0; rr < 16; ++rr) { const size_t m = (size_t)(row0 + rr);
        { bf16* gp = GO + m * 1024 + 16 * lane; const bf16* pg = P + m * NP + PC_G + 16 * lane;
          const v4u a = *(const v4u*)gp, b = *(const v4u*)(gp + 8), ga = *(const v4u*)pg, gb = *(const v4u*)(pg + 8);
          float o[16] = {blo(a.x), bhi(a.x), blo(a.y), bhi(a.y), blo(a.z), bhi(a.z), blo(a.w), bhi(a.w), blo(b.x), bhi(b.x), blo(b.y), bhi(b.y), blo(b.z), bhi(b.z), blo(b.w), bhi(b.w)};
          float g[16] = {blo(ga.x), bhi(ga.x), blo(ga.y), bhi(ga.y), blo(ga.z), bhi(ga.z), blo(ga.w), bhi(ga.w), blo(gb.x), bhi(gb.x), blo(gb.y), bhi(gb.y), blo(gb.z), bhi(gb.z), blo(gb.w), bhi(gb.w)};
          float ss = 0.f;
#pragma unroll
          for (int i = 0; i < 16; ++i) ss += o[i] * o[i];
          ss = rowsum16(ss);
          const float rs = __builtin_amdgcn_rsqf(ss * (1.0f / 256.0f) + 1e-5f);
#pragma unroll
          for (int i = 0; i < 16; ++i) o[i] = o[i] * rs * ng[i] * (g[i] * sigmoidf_(g[i]));
          v4u w0, w1; w0.x = pk2(o[0], o[1]); w0.y = pk2(o[2], o[3]); w0.z = pk2(o[4], o[5]); w0.w = pk2(o[6], o[7]); w1.x = pk2(o[8], o[9]); w1.y = pk2(o[10], o[11]); w1.z = pk2(o[12], o[13]); w1.w = pk2(o[14], o[15]);
          bf16* gq = GOo + m * 1024 + 16 * lane; *(v4u*)gq = w0; *(v4u*)(gq + 8) = w1; }
        { bf16* yp = RY + m * 512 + 8 * lane; const v4u a = *(const v4u*)yp, vv = *(const v4u*)(RV + m * 512 + 8 * lane), gg = *(const v4u*)(RG + m * 512 + 8 * lane);
          float y[8] = {blo(a.x), bhi(a.x), blo(a.y), bhi(a.y), blo(a.z), bhi(a.z), blo(a.w), bhi(a.w)};
          float v[8] = {blo(vv.x), bhi(vv.x), blo(vv.y), bhi(vv.y), blo(vv.z), bhi(vv.z), blo(vv.w), bhi(vv.w)};
          float g[8] = {blo(gg.x), bhi(gg.x), blo(gg.y), bhi(gg.y), blo(gg.z), bhi(gg.z), blo(gg.w), bhi(gg.w)};
          float s = 0.f;
#pragma unroll
          for (int i = 0; i < 8; ++i) s += y[i];
          s = sum8(s);
          const float mean = s * (1.0f / 64.0f); float q = 0.f;
#pragma unroll
          for (int i = 0; i < 8; ++i) { y[i] -= mean; q += y[i] * y[i]; }
          q = sum8(q);
          const float rs = __builtin_amdgcn_rsqf(q * (1.0f / 64.0f) + 64e-5f);
          const float bc = BC[m * 8 + (lane >> 3)];
#pragma unroll
          for (int i = 0; i < 8; ++i) y[i] = (y[i] * rs * lg[i] + lb[i] + bc * v[i]) * g[i];
          v4u w; w.x = pk2(y[0], y[1]); w.y = pk2(y[2], y[3]); w.z = pk2(y[4], y[5]); w.w = pk2(y[6], y[7]);
          *(v4u*)(RYo + m * 512 + 8 * lane) = w; }
    }
}

typedef short bf16x8v __attribute__((ext_vector_type(8)));
__device__ __forceinline__ void phase_gla_d1(Frame& F, const Args& A, int l, int wsel, int nwg) {
    const int tid = F.tid, lane = F.lane, w = F.wave, d = tid & 127, rq = tid >> 7;
    LAS float* sPA = (LAS float*)F.lds;
    LAS float* sTot = sPA + 1024;
    LAS bf16* sQE = (LAS bf16*)(F.lds + 8192);
    LAS bf16* sKE = (LAS bf16*)(F.lds + 8192 + 17408);
    LAS bf16* sV = (LAS bf16*)(F.lds + 8192 + 2 * 17408);
    const bf16* P = WSP(const bf16, WS_P);
    bf16* QE = WSP(bf16, WS_QE); bf16* KDT = WSP(bf16, WS_KDT); bf16* ATT = WSP(bf16, WS_ATT); float* DL = WSP(float, WS_DL);
    const float* au = A.in[7] + (size_t)l * 16 * 512; const float* ab = A.in[8] + (size_t)l * 512;
    const float scale = 0.08838834764831845f;
    const int h = wsel & 3, cg = wsel >> 2, npw = 2048 / nwg;
    float auv[16];
#pragma unroll
    for (int r = 0; r < 16; ++r) auv[r] = au[r * 512 + h * 128 + d];
    const float abv = ab[h * 128 + d];
    unsigned g_pa; v4u g_q[2], g_k[2];
#define D1_ISSUE(bn_) do { const size_t m0_ = (size_t)((bn_) >> 5) * 2048 + (size_t)((bn_) & 31) * 64; \
        g_pa = *(const unsigned*)(P + (m0_ + (tid >> 3)) * NP + PC_PA + (tid & 7) * 2); \
        _Pragma("unroll") for (int i = 0; i < 2; ++i) { const int idx = tid + 512 * i; g_q[i] = *(const v4u*)(P + (m0_ + (idx >> 4)) * NP + PC_Q + h * 128 + (idx & 15) * 8); \
                                                          g_k[i] = *(const v4u*)(P + (m0_ + (idx >> 4)) * NP + PC_K + h * 128 + (idx & 15) * 8); } } while (0)
    D1_ISSUE(cg * npw);
    for (int ui = 0; ui < npw; ++ui) {
        const int bn = cg * npw + ui, u = bn * 4 + h;
        sPA[tid * 2] = blo(g_pa); sPA[tid * 2 + 1] = bhi(g_pa);
#pragma unroll
        for (int i = 0; i < 2; ++i) { const int idx = tid + 512 * i; *(LAS v4u*)(sQE + (idx >> 4) * 136 + (idx & 15) * 8) = g_q[i]; *(LAS v4u*)(sKE + (idx >> 4) * 136 + (idx & 15) * 8) = g_k[i]; }
        __syncthreads();
        if (ui + 1 < npw) D1_ISSUE(bn + 1);
        float c[16]; float run = 0.f;
#pragma unroll
        for (int rr = 0; rr < 16; ++rr) { const int row = rq * 16 + rr; float z = abv;
#pragma unroll
            for (int r4 = 0; r4 < 4; ++r4) { const f32x4 pv = *(const LAS f32x4*)(sPA + row * 16 + r4 * 4); z += pv.x * auv[4 * r4] + pv.y * auv[4 * r4 + 1] + pv.z * auv[4 * r4 + 2] + pv.w * auv[4 * r4 + 3]; }
            run += -softplusf_(-z) * 0.0625f; c[rr] = run; }
        sTot[rq * 128 + d] = run;
        __syncthreads();
        float offs = 0.f, btot = 0.f;
#pragma unroll
        for (int q = 0; q < 4; ++q) { const float t = sTot[q * 128 + d]; btot += t; offs += (q < rq) ? t : 0.f; }
        unsigned kdp[8];
#pragma unroll
        for (int rr = 0; rr < 16; ++rr) { const int row = rq * 16 + rr; const float bc = offs + c[rr];
            const float q = bf2f(sQE[row * 136 + d]) * scale, k = bf2f(sKE[row * 136 + d]);
            const unsigned qe = f2bf(q * fexp_(bc)), ke = f2bf(k * fexp_(-bc)), kd = f2bf(k * fexp_(btot - bc));
            sQE[row * 136 + d] = (bf16)qe; sKE[row * 136 + d] = (bf16)ke;
            if (rr & 1) kdp[rr >> 1] |= kd << 16; else kdp[rr >> 1] = kd; }
        { bf16* kp = KDT + (((size_t)u * 16 + ((d >> 6) * 4 + ((d >> 4) & 3)) * 2 + (rq >> 1)) * 64 + (d & 15) + 16 * ((rq & 1) * 2)) * 8; v4u a, b; a.x = kdp[0]; a.y = kdp[1]; a.z = kdp[2]; a.w = kdp[3]; b.x = kdp[4]; b.y = kdp[5]; b.z = kdp[6]; b.w = kdp[7];
          *(v4u*)kp = a; *(v4u*)(kp + 128) = b; }
        if (rq == 0) DL[(size_t)u * 128 + d] = fexp_(btot);
        __syncthreads();
#pragma unroll
        for (int i = 0; i < 2; ++i) { const int pi = tid + 512 * i, blk = pi >> 6, ln = pi & 63, row = (blk >> 2) * 16 + (ln & 15), d0 = ((blk >> 1) & 1) * 64 + (blk & 1) * 32 + (ln >> 4) * 4;
            const v2u lo = *(const LAS v2u*)(sQE + row * 136 + d0), hi = *(const LAS v2u*)(sQE + row * 136 + d0 + 16);
            v4u o; o.x = lo.x; o.y = lo.y; o.z = hi.x; o.w = hi.y; *(v4u*)(QE + (((size_t)u * 16 + blk) * 64 + ln) * 8) = o; }
        { const int jt = w & 3, l15 = lane & 15, kq = lane >> 4;
#pragma unroll
          for (int ii = 0; ii < 2; ++ii) { const int it = 2 * (w >> 2) + ii; pg8::f32x4 acc = {0.f, 0.f, 0.f, 0.f};
            if (it >= jt) {
#pragma unroll
                for (int ks = 0; ks < 4; ++ks) { const bf16x8v a = *(const LAS bf16x8v*)(sKE + (jt * 16 + l15) * 136 + ks * 32 + kq * 8), b = *(const LAS bf16x8v*)(sQE + (it * 16 + l15) * 136 + ks * 32 + kq * 8);
                    acc = __builtin_amdgcn_mfma_f32_16x16x32_bf16(a, b, acc, 0, 0, 0); } }
            const int i = it * 16 + l15, j0 = jt * 16 + kq * 4;
            v2u o; o.x = pk2(i >= j0 ? acc[0] : 0.f, i >= j0 + 1 ? acc[1] : 0.f); o.y = pk2(i >= j0 + 2 ? acc[2] : 0.f, i >= j0 + 3 ? acc[3] : 0.f);
            *(v2u*)(ATT + (((size_t)u * 8 + it * 2 + (jt >> 1)) * 64 + l15 + 16 * ((jt & 1) * 2 + (kq >> 1))) * 8 + (kq & 1) * 4) = o; } }
        __syncthreads();
    }
#undef D1_ISSUE
}

typedef float f32x2g __attribute__((ext_vector_type(2))); typedef __bf16 bf16x2g __attribute__((ext_vector_type(2)));
__device__ __forceinline__ unsigned cvtpk(float lo, float hi) { const f32x2g v = {lo, hi}; const bf16x2g r = __builtin_convertvector(v, bf16x2g); return __builtin_bit_cast(unsigned, r); }
__device__ __forceinline__ bf16x8v as_bf8(v4u x) { return __builtin_bit_cast(bf16x8v, x); }
__device__ __forceinline__ void phase_gla_d2(Frame& F, const Args& A) {
    const int wgi = F.vcu, b = wgi >> 4, h = (wgi >> 2) & 3, vq = wgi & 3, w = F.wave, lane = F.lane;
    const int vb = w & 3, half = w >> 2, l15 = lane & 15, kq = lane >> 4;
    LAS pg8::f32x4* sO = (LAS pg8::f32x4*)F.lds;
    LAS unsigned char* sVc = F.lds + 32768;
    LAS unsigned char* ring = F.lds + 49152;
    const bf16* P = WSP(const bf16, WS_P);
    const int vst = F.tid >> 3, vsc = F.tid & 7;
    const unsigned vtr_addr = (unsigned)(size_t)(sVc) + (unsigned)((8 * kq + (l15 >> 2)) * 128 + (16 * vb + 4 * (l15 & 3)) * 2);
    const bf16* QE = WSP(const bf16, WS_QE); const bf16* KDT = WSP(const bf16, WS_KDT); const bf16* ATT = WSP(const bf16, WS_ATT); const float* DL = WSP(const float, WS_DL);
    bf16* GO = WSP(bf16, WS_GO);
    pg8::f32x4 S[4];
#pragma unroll
    for (int i = 0; i < 4; ++i) S[i] = (pg8::f32x4){0.f, 0.f, 0.f, 0.f};
    v4u vt[2]; pg8::f32x4 dl[4]; v4u vstage;
#define GLA_DMA(slot_, n_) do { const size_t u_ = ((size_t)b * 32 + (n_)) * 4 + h; _Pragma("unroll") for (int i = 0; i < 5; ++i) { const int blk = w + 8 * i; \
        const bf16* src = blk < 16 ? QE + (u_ * 16 + blk) * 512 : (blk < 24 ? ATT + (u_ * 8 + (blk - 16)) * 512 : KDT + (u_ * 16 + (blk - 24)) * 512); \
        __builtin_amdgcn_global_load_lds((const unsigned*)(src + lane * 8), (LAS unsigned*)(ring + (slot_) * 40960 + blk * 1024), 16, 0, 0); } } while (0)
#define GLA_FRAG(slot_, blk_) (*(const LAS v4u*)(ring + (slot_) * 40960 + (blk_) * 1024 + lane * 16))
#define GLA_LOAD_V(n_) do { vstage = *(const v4u*)(P + ((size_t)b * 2048 + (size_t)(n_) * 64 + vst) * NP + PC_V + h * 256 + vq * 64 + vsc * 8); } while (0)
#define GLA_STORE_V(buf_) do { *(LAS v4u*)(sVc + (buf_) * 8192 + vst * 128 + vsc * 16) = vstage; } while (0)
#define GLA_READ_VT(buf_) do { _Pragma("unroll") for (int ks = 0; ks < 2; ++ks) { v2u lo_, hi_; \
        asm volatile("ds_read_b64_tr_b16 %0, %1" : "=&v"(lo_) : "v"(vtr_addr + (buf_) * 8192 + ks * 4096) : "memory"); asm volatile("ds_read_b64_tr_b16 %0, %1" : "=&v"(hi_) : "v"(vtr_addr + (buf_) * 8192 + ks * 4096 + 512) : "memory"); \
        asm volatile("s_waitcnt lgkmcnt(0)" : "+v"(lo_), "+v"(hi_) :: "memory"); vt[ks].x = lo_.x; vt[ks].y = lo_.y; vt[ks].z = hi_.x; vt[ks].w = hi_.y; } } while (0)
#define GLA_LOAD_DL(n_) do { const size_t u_ = ((size_t)b * 32 + (n_)) * 4 + h; _Pragma("unroll") for (int dt = 0; dt < 4; ++dt) dl[dt] = *(const pg8::f32x4*)(DL + u_ * 128 + half * 64 + dt * 16 + kq * 4); } while (0)
    GLA_DMA(0, 0); GLA_LOAD_DL(0); GLA_LOAD_V(0); GLA_STORE_V(0);
    asm volatile("s_waitcnt vmcnt(0) lgkmcnt(0)" ::: "memory"); __builtin_amdgcn_s_barrier(); asm volatile("" ::: "memory");
    for (int n = 0; n < 32; ++n) {
        const size_t m0 = (size_t)b * 2048 + (size_t)n * 64; const int slot = n & 1;
        if (n + 1 < 32) { GLA_DMA(slot ^ 1, n + 1); GLA_LOAD_V(n + 1); }
        GLA_READ_VT(n & 1);
        v4u sf[2];
#pragma unroll
        for (int ks = 0; ks < 2; ++ks) { sf[ks].x = cvtpk(S[2 * ks][0], S[2 * ks][1]); sf[ks].y = cvtpk(S[2 * ks][2], S[2 * ks][3]); sf[ks].z = cvtpk(S[2 * ks + 1][0], S[2 * ks + 1][1]); sf[ks].w = cvtpk(S[2 * ks + 1][2], S[2 * ks + 1][3]); }
        pg8::f32x4 acc[4];
#pragma unroll
        for (int it = 0; it < 4; ++it) { acc[it] = (pg8::f32x4){0.f, 0.f, 0.f, 0.f};
            acc[it] = __builtin_amdgcn_mfma_f32_16x16x32_bf16(as_bf8(vt[half]), as_bf8(GLA_FRAG(slot, 16 + it * 2 + half)), acc[it], 0, 0, 0);
#pragma unroll
            for (int ks = 0; ks < 2; ++ks) acc[it] = __builtin_amdgcn_mfma_f32_16x16x32_bf16(as_bf8(sf[ks]), as_bf8(GLA_FRAG(slot, (it * 2 + half) * 2 + ks)), acc[it], 0, 0, 0); }
#pragma unroll
        for (int dt = 0; dt < 4; ++dt) { S[dt] = S[dt] * dl[dt];
#pragma unroll
            for (int ks = 0; ks < 2; ++ks) S[dt] = __builtin_amdgcn_mfma_f32_16x16x32_bf16(as_bf8(GLA_FRAG(slot, 24 + (half * 4 + dt) * 2 + ks)), as_bf8(vt[ks]), S[dt], 0, 0, 0); }
        if (n + 1 < 32) GLA_LOAD_DL(n + 1);
        const int buf = n & 1;
#pragma unroll
        for (int ii = 0; ii < 2; ++ii) sO[((buf * 8 + w) * 2 + ii) * 64 + lane] = half ? acc[ii] : acc[2 + ii];
        if (n + 1 < 32) GLA_STORE_V((n + 1) & 1);
        asm volatile("s_waitcnt vmcnt(0) lgkmcnt(0)" ::: "memory"); __builtin_amdgcn_s_barrier(); asm volatile("" ::: "memory");
#pragma unroll
        for (int ii = 0; ii < 2; ++ii) { const int t = half ? 2 + ii : ii; const pg8::f32x4 o = (half ? acc[2 + ii] : acc[ii]) + sO[((buf * 8 + (w ^ 4)) * 2 + ii) * 64 + lane];
            v2u ov; ov.x = cvtpk(o[0], o[1]); ov.y = cvtpk(o[2], o[3]);
            *(v2u*)(GO + (m0 + t * 16 + l15) * 1024 + h * 256 + vq * 64 + vb * 16 + kq * 4) = ov; }
    }
#undef GLA_DMA
#undef GLA_FRAG
#undef GLA_LOAD_V
#undef GLA_STORE_V
#undef GLA_READ_VT
#undef GLA_LOAD_DL
}


typedef float f32x2c __attribute__((ext_vector_type(2))); typedef __bf16 bf16x2c __attribute__((ext_vector_type(2)));
__device__ __forceinline__ unsigned cvtpk_(float lo, float hi) { const f32x2c v = {lo, hi}; const bf16x2c r = __builtin_convertvector(v, bf16x2c); return __builtin_bit_cast(unsigned, r); }
__device__ __forceinline__ unsigned cvtpk_a(float lo, float hi) { unsigned r; asm("v_cvt_pk_bf16_f32 %0, %1, %2" : "=v"(r) : "v"(lo), "v"(hi)); return r; }
__device__ __forceinline__ v4u opf1(const pg8::f32x4& x) { v4u r; r.x = cvtpk_(x[0], x[1]); r.y = cvtpk_(x[2], x[3]); r.z = 0u; r.w = 0u; return r; }
__device__ __forceinline__ v4u opf2(const pg8::f32x4& x, const pg8::f32x4& y) { v4u r; r.x = cvtpk_(x[0], x[1]); r.y = cvtpk_(x[2], x[3]); r.z = cvtpk_(y[0], y[1]); r.w = cvtpk_(y[2], y[3]); return r; }
#define RMF(a, b, c) __builtin_amdgcn_mfma_f32_16x16x32_bf16(as_bf8(a), as_bf8(b), (c), 0, 0, 0)
template <int N> __device__ __forceinline__ float dpp_shr_add(float x) { return x + __builtin_bit_cast(float, __builtin_amdgcn_update_dpp(0, __builtin_bit_cast(int, x), 0x110 + N, 0xf, 0xf, true)); }

__device__ __forceinline__ unsigned scale_pk(unsigned w, float s) { return cvtpk_a(blo(w) * s, bhi(w) * s); }
#ifdef NO_CSTORE
#define CST if (0)
#else
#define CST
#endif
#ifdef NO_CSTORE2
#define CST2 if (0)
#else
#define CST2
#endif
__device__ __forceinline__ void rwkv_chunk_ops(Frame& F, size_t unit, size_t m, int hd, int lane, float inv,
                                               const v4u (&kaf)[2], const v4u (&kbf)[2], const v4u (&rf)[2], const v4u (&kf)[2], const v4u (&vf)[2]) {
    const int l15 = lane & 15, kq = lane >> 4;
    const pg8::f32x4 z4 = {0.f, 0.f, 0.f, 0.f};
    v4u af[2], bfr[2];
#pragma unroll
    for (int s = 0; s < 2; ++s) { af[s].x = scale_pk(kaf[s].x, -inv); af[s].y = scale_pk(kaf[s].y, -inv); af[s].z = scale_pk(kaf[s].z, -inv); af[s].w = scale_pk(kaf[s].w, -inv);
        bfr[s].x = scale_pk(kbf[s].x, inv); bfr[s].y = scale_pk(kbf[s].y, inv); bfr[s].z = scale_pk(kbf[s].z, inv); bfr[s].w = scale_pk(kbf[s].w, inv); }
    pg8::f32x4 dN = RMF(bfr[1], af[1], RMF(bfr[0], af[0], z4)), dNt = RMF(af[1], bfr[1], RMF(af[0], bfr[0], z4)), dKAt = RMF(af[1], kf[1], RMF(af[0], kf[0], z4));
    pg8::f32x4 dNbr = RMF(bfr[1], rf[1], RMF(bfr[0], rf[0], z4)), dNkr = RMF(kf[1], rf[1], RMF(kf[0], rf[0], z4));
    pg8::f32x4 P, Pt;
#pragma unroll
    for (int e = 0; e < 4; ++e) { const int row = kq * 4 + e; const float idv = (row == l15) ? 1.f : 0.f;
        dN[e] = (row < l15) ? dN[e] : 0.f; dNt[e] = (l15 < row) ? dNt[e] : 0.f; dKAt[e] = (l15 < row) ? dKAt[e] : 0.f;
        dNbr[e] = (row <= l15) ? dNbr[e] : 0.f; dNkr[e] = (row <= l15) ? dNkr[e] : 0.f; P[e] = dN[e] + idv; Pt[e] = dNt[e] + idv; }
    { pg8::f32x4 X = dN, Xt = dNt;
#pragma unroll
      for (int it = 0; it < 3; ++it) { const v4u aX = opf1(X), aXt = opf1(Xt); const pg8::f32x4 X2 = RMF(aXt, aX, z4), X2t = RMF(aX, aXt, z4);
          const v4u aPt = opf1(Pt), aX2 = opf1(X2); P = RMF(aPt, aX2, P); Pt = RMF(aX2, aPt, Pt); X = X2; Xt = X2t; } }
    const v4u oT = opf1(P);
    const pg8::f32x4 M2 = RMF(opf1(Pt), opf1(dNbr), z4), P2 = RMF(opf1(dKAt), oT, z4);
    const v4u oM2 = opf1(M2), oP2 = opf1(P2), oNN = opf2(dNbr, dNkr);
    v4u sel[2];
#pragma unroll
    for (int p = 0; p < 2; ++p) { const int idx = 4 * p + (l15 & 3); const bool on = (l15 >> 2) == kq; unsigned wv[4] = {0u, 0u, 0u, 0u}; wv[idx >> 1] = on ? ((idx & 1) ? 0x3F800000u : 0x00003F80u) : 0u; sel[p].x = wv[0]; sel[p].y = wv[1]; sel[p].z = wv[2]; sel[p].w = wv[3]; }
    bf16* P1T = WSP(bf16, WS_P1T); bf16* Q1T = WSP(bf16, WS_Q1T); bf16* BKT = WSP(bf16, WS_BKT); bf16* VTR = WSP(bf16, WS_VTR); bf16* ULT = WSP(bf16, WS_ULT); bf16* RY = WSP(bf16, WS_RY);
    pg8::f32x4 p1prev, q1prev; v2u ryp[4];
#pragma unroll
    for (int j = 0; j < 4; ++j) { const int s = j >> 1, p = j & 1;
        const v4u oA = opf1(RMF(af[s], sel[p], z4));
        const unsigned rw0 = p ? rf[s].z : rf[s].x, rw1 = p ? rf[s].w : rf[s].y;
        const pg8::f32x4 p1 = RMF(oA, oT, z4), q1 = RMF(oA, oM2, ((pg8::f32x4){blo(rw0), bhi(rw0), blo(rw1), bhi(rw1)}));
        if (p) { CST *(v4u*)(P1T + ((unit * 2 + s) * 64 + lane) * 8) = opf2(p1prev, p1); CST *(v4u*)(Q1T + ((unit * 2 + s) * 64 + lane) * 8) = opf2(q1prev, q1); } else { p1prev = p1; q1prev = q1; }
        const pg8::f32x4 dB = RMF(bfr[s], sel[p], z4), dK = RMF(kf[s], sel[p], z4), dV = RMF(vf[s], sel[p], z4);
        CST *(v4u*)(BKT + ((unit * 4 + j) * 64 + lane) * 8) = opf2(dB, dK);
        const v4u oV = opf1(dV);
        CST *(v2u*)(VTR + ((unit * 4 + j) * 64 + lane) * 4) = (v2u){oV.x, oV.y};
        const pg8::f32x4 ul = RMF(oP2, oV, z4);
        const v4u oU = opf1(ul);
        CST *(v2u*)(ULT + ((unit * 4 + j) * 64 + lane) * 4) = (v2u){oU.x, oU.y};
        v4u aUV; aUV.x = oU.x; aUV.y = oU.y; aUV.z = oV.x; aUV.w = oV.y;
        const pg8::f32x4 yl = RMF(aUV, oNN, z4);
        ryp[j] = (v2u){cvtpk_(yl[0], yl[1]), cvtpk_(yl[2], yl[3])};
        __builtin_amdgcn_sched_barrier(0); }
#pragma unroll
    for (int j = 0; j < 4; ++j) *(v2u*)(RY + m * 512 + hd * 64 + j * 16 + kq * 4) = ryp[j];
}

__device__ __forceinline__ void rwkv_seq_body(Frame& F, const bf16* __restrict__ RYr, bf16* __restrict__ RYw) {
    if (F.vcu >= 128 || F.wave >= 4) return;
    const int b = F.vcu >> 3, h = F.vcu & 7, vb = F.wave, lane = F.lane, l15 = lane & 15, kq = lane >> 4;
    const bf16* P1T = WSP(const bf16, WS_P1T); const bf16* Q1T = WSP(const bf16, WS_Q1T); const bf16* BKT = WSP(const bf16, WS_BKT); const bf16* VTR = WSP(const bf16, WS_VTR); const bf16* ULT = WSP(const bf16, WS_ULT);
    const float* WC = WSP(const float, WS_WC);
    pg8::f32x4 St[4];
#pragma unroll
    for (int j = 0; j < 4; ++j) St[j] = (pg8::f32x4){0.f, 0.f, 0.f, 0.f};
    v4u p1[2][2], q1[2][2], bk[2][4]; v2u vt[2], ul[2], ry[2]; f32x4 wc[2][4];
#define RS_LOAD(S_, n_) do { const size_t u_ = ((size_t)b * 128 + (n_)) * 8 + h; \
        _Pragma("unroll") for (int s = 0; s < 2; ++s) { p1[S_][s] = *(const v4u*)(P1T + ((u_ * 2 + s) * 64 + lane) * 8); q1[S_][s] = *(const v4u*)(Q1T + ((u_ * 2 + s) * 64 + lane) * 8); } \
        _Pragma("unroll") for (int j = 0; j < 4; ++j) { bk[S_][j] = *(const v4u*)(BKT + ((u_ * 4 + j) * 64 + lane) * 8); wc[S_][j] = *(const f32x4*)(WC + u_ * 64 + j * 16 + kq * 4); } \
        vt[S_] = *(const v2u*)(VTR + ((u_ * 4 + vb) * 64 + lane) * 4); ul[S_] = *(const v2u*)(ULT + ((u_ * 4 + vb) * 64 + lane) * 4); \
        ry[S_] = *(const v2u*)(RYr + ((size_t)b * 2048 + (size_t)(n_) * 16 + l15) * 512 + h * 64 + vb * 16 + kq * 4); } while (0)
#define RS_STEP(S_, n_) do { \
        const v4u sf0 = opf2(St[0], St[1]), sf1 = opf2(St[2], St[3]); \
        pg8::f32x4 U = {blo(ul[S_].x), bhi(ul[S_].x), blo(ul[S_].y), bhi(ul[S_].y)}; \
        U = RMF(p1[S_][0], sf0, U); U = RMF(p1[S_][1], sf1, U); \
        pg8::f32x4 Y = {blo(ry[S_].x), bhi(ry[S_].x), blo(ry[S_].y), bhi(ry[S_].y)}; \
        Y = RMF(sf0, q1[S_][0], Y); Y = RMF(sf1, q1[S_][1], Y); \
        *(v2u*)(RYw + ((size_t)b * 2048 + (size_t)(n_) * 16 + l15) * 512 + h * 64 + vb * 16 + kq * 4) = (v2u){cvtpk_(Y[0], Y[1]), cvtpk_(Y[2], Y[3])}; \
        v4u uf; uf.x = cvtpk_(U[0], U[1]); uf.y = cvtpk_(U[2], U[3]); uf.z = vt[S_].x; uf.w = vt[S_].y; \
        _Pragma("unroll") for (int j = 0; j < 4; ++j) { St[j] = RMF(bk[S_][j], uf, St[j]); St[j][0] *= wc[S_][j].x; St[j][1] *= wc[S_][j].y; St[j][2] *= wc[S_][j].z; St[j][3] *= wc[S_][j].w; } } while (0)
    RS_LOAD(0, 0); RS_LOAD(1, 1);
    for (int n = 0; n < 128; n += 2) {
        RS_STEP(0, n); __builtin_amdgcn_sched_barrier(0); if (n + 2 < 128) RS_LOAD(0, n + 2); __builtin_amdgcn_sched_barrier(0);
        RS_STEP(1, n + 1); __builtin_amdgcn_sched_barrier(0); if (n + 3 < 128) RS_LOAD(1, n + 3); __builtin_amdgcn_sched_barrier(0);
    }
#undef RS_STEP
#undef RS_LOAD
}
__device__ __forceinline__ void phase_rwkv_seq(Frame& F, const Args& A) { rwkv_seq_body(F, WSP(const bf16, WS_RY), WSP(bf16, WS_RY)); }

__device__ __forceinline__ void phase_rwkv_prep3(Frame& F, const Args& A, int l) {
    const int gw = F.vcu * NWAVES + F.wave, lane = F.lane, tid = F.tid, l15 = lane & 15, kq = lane >> 4;
    const size_t m = (size_t)gw * 16 + l15; const bool first = (m & 2047) == 0; const size_t mp = first ? m : m - 1;
    const bf16* P = WSP(const bf16, WS_P); const float* mu = A.in[11] + (size_t)l * 1792;
    const bf16* LF = WSP(const bf16, WS_W2T);
    bf16* RV = WSP(bf16, WS_RV); bf16* RG = WSP(bf16, WS_RG);
    float* BC = WSP(float, WS_BC);
    LAS unsigned char* wbuf = F.lds;
    LAS float* cbuf = (LAS float*)(F.lds + 65536);
    const float* cptr; { const int arr = tid >> 6, ch = tid & 63;
        cptr = arr == 0 ? A.in[12] + (size_t)l * 512 + ch : arr == 1 ? A.in[14] + (size_t)l * 512 + ch : arr == 2 ? A.in[17] + (size_t)l * 512 + ch : arr == 3 ? A.in[18] + (size_t)l * 512 + ch :
               arr == 4 ? A.in[19] + (size_t)l * 512 + ch : arr == 5 ? mu + ch : arr == 6 ? mu + 576 + ch : mu + 1088 + ch; }
    float g_c;
#define RP_ISSUE(hd_, buf_) do { _Pragma("unroll") for (int i = 0; i < 4; ++i) __builtin_amdgcn_global_load_lds((const unsigned*)(LF + ((size_t)(hd_) * 2048 + (i * 8 + F.wave) * 64 + lane) * 8), (LAS unsigned*)(wbuf + (buf_) * 32768 + (i * 8 + F.wave) * 1024), 16, 0, 0); g_c = cptr[(hd_) * 64]; } while (0)
#define RP_WRITE(buf_) do { cbuf[(buf_) * 512 + tid] = g_c; } while (0)
    RP_ISSUE(0, 0);
    const v4u zero4 = {0u, 0u, 0u, 0u}; const v2u z2 = {0u, 0u};
    LAS unsigned char* xfl = F.lds + 69632 + F.wave * 8192 + lane * 16;
#pragma unroll
    for (int f = 0; f < 8; ++f) { int pc, mi; if (f < 2) { pc = PC_WD + f * 32; mi = 512 + f * 32; } else if (f < 4) { pc = PC_AD + (f - 2) * 32; mi = 1600 + (f - 2) * 32; } else { pc = PC_GD + (f - 4) * 32; mi = 1664 + (f - 4) * 32; }
        pc += kq * 8; mi += kq * 8;
        const v4u cu = *(const v4u*)(P + m * NP + pc); const v4u pr = first ? zero4 : *(const v4u*)(P + (m - 1) * NP + pc);
        const f32x4 mu0 = *(const f32x4*)(mu + mi), mu1 = *(const f32x4*)(mu + mi + 4);
        float c[8] = {blo(cu.x), bhi(cu.x), blo(cu.y), bhi(cu.y), blo(cu.z), bhi(cu.z), blo(cu.w), bhi(cu.w)};
        float p[8] = {blo(pr.x), bhi(pr.x), blo(pr.y), bhi(pr.y), blo(pr.z), bhi(pr.z), blo(pr.w), bhi(pr.w)};
        float mm[8] = {mu0.x, mu0.y, mu0.z, mu0.w, mu1.x, mu1.y, mu1.z, mu1.w};
#pragma unroll
        for (int j = 0; j < 8; ++j) { const float xs = c[j] + (p[j] - c[j]) * mm[j]; c[j] = f < 2 ? tanhf_(xs) : (f < 4 ? xs : sigmoidf_(xs)); }
        v4u xv; xv.x = pk2(c[0], c[1]); xv.y = pk2(c[2], c[3]); xv.z = pk2(c[4], c[5]); xv.w = pk2(c[6], c[7]); *(LAS v4u*)(xfl + f * 1024) = xv; }
    v2u pc_[4][3], pp_[4][3];
#define RP_LOADH(hd_) do { _Pragma("unroll") for (int j_ = 0; j_ < 4; ++j_) { const int c0_ = ((hd_) * 4 + j_) * 16 + kq * 4; \
        pc_[j_][0] = *(const v2u*)(P + m * NP + PC_R + c0_); pc_[j_][1] = *(const v2u*)(P + m * NP + PC_RK + c0_); pc_[j_][2] = *(const v2u*)(P + m * NP + PC_RV + c0_); \
        pp_[j_][0] = *(const v2u*)(P + mp * NP + PC_R + c0_); pp_[j_][1] = *(const v2u*)(P + mp * NP + PC_RK + c0_); pp_[j_][2] = *(const v2u*)(P + mp * NP + PC_RV + c0_); \
        if (first) { pp_[j_][0] = z2; pp_[j_][1] = z2; pp_[j_][2] = z2; } } } while (0)
    RP_WRITE(0);
    asm volatile("s_waitcnt vmcnt(0)" ::: "memory");
    __syncthreads();
    for (int hd = 0; hd < 8; ++hd) {
        const int buf = hd & 1;
        if (hd + 1 < 8) RP_ISSUE(hd + 1, buf ^ 1);
        RP_LOADH(hd);
        const LAS unsigned char* wb = wbuf + buf * 32768 + lane * 16; const LAS float* cb = cbuf + buf * 512;
        v4u kaf[2], kbf[2], rf[2], kf[2], vf[2]; v2u rvp[4], rgp[4]; float ssq = 0.f, bcs = 0.f;
#pragma unroll
        for (int j = 0; j < 4; ++j) { const int ct = hd * 4 + j, c0 = ct * 16 + kq * 4, cl = j * 16 + kq * 4;
            const v2u cr = pc_[j][0], ck = pc_[j][1], cv = pc_[j][2], pr = pp_[j][0], pk = pp_[j][1], pv = pp_[j][2];
            pg8::f32x4 aw = {0.f, 0.f, 0.f, 0.f}, aa = aw, ag = aw;
#pragma unroll
            for (int ks = 0; ks < 2; ++ks) { aw = __builtin_amdgcn_mfma_f32_16x16x32_bf16(as_bf8(*(const LAS v4u*)(wb + (j * 8 + ks) * 1024)), as_bf8(*(const LAS v4u*)(xfl + ks * 1024)), aw, 0, 0, 0);
                                              aa = __builtin_amdgcn_mfma_f32_16x16x32_bf16(as_bf8(*(const LAS v4u*)(wb + (j * 8 + 2 + ks) * 1024)), as_bf8(*(const LAS v4u*)(xfl + (2 + ks) * 1024)), aa, 0, 0, 0); }
#pragma unroll
            for (int ks = 0; ks < 4; ++ks) ag = __builtin_amdgcn_mfma_f32_16x16x32_bf16(as_bf8(*(const LAS v4u*)(wb + (j * 8 + 4 + ks) * 1024)), as_bf8(*(const LAS v4u*)(xfl + (4 + ks) * 1024)), ag, 0, 0, 0);
            const f32x4 w0 = *(const LAS f32x4*)(cb + cl), a0 = *(const LAS f32x4*)(cb + 64 + cl), kkc = *(const LAS f32x4*)(cb + 128 + cl), kac = *(const LAS f32x4*)(cb + 192 + cl), rkc = *(const LAS f32x4*)(cb + 256 + cl);
            const f32x4 mur = *(const LAS f32x4*)(cb + 320 + cl), muk = *(const LAS f32x4*)(cb + 384 + cl), muv = *(const LAS f32x4*)(cb + 448 + cl);
            const float crf[4] = {blo(cr.x), bhi(cr.x), blo(cr.y), bhi(cr.y)}, ckf[4] = {blo(ck.x), bhi(ck.x), blo(ck.y), bhi(ck.y)}, cvf[4] = {blo(cv.x), bhi(cv.x), blo(cv.y), bhi(cv.y)};
            const float prf[4] = {blo(pr.x), bhi(pr.x), blo(pr.y), bhi(pr.y)}, pkf[4] = {blo(pk.x), bhi(pk.x), blo(pk.y), bhi(pk.y)}, pvf[4] = {blo(pv.x), bhi(pv.x), blo(pv.y), bhi(pv.y)};
            float vo[4], go[4], kt_[4], wcv[4], rt_[4], ka_[4], kb_[4];
#pragma unroll
            for (int e = 0; e < 4; ++e) { const float r = crf[e] + (prf[e] - crf[e]) * mur[e], k = ckf[e] + (pkf[e] - ckf[e]) * muk[e], v = cvf[e] + (pvf[e] - cvf[e]) * muv[e];
                const float wl = -softplusf_(-(w0[e] + aw[e])) - 0.5f; const float lw = -fexp_(wl);
                const float a = sigmoidf_(a0[e] + aa[e]); const float kk = k * kkc[e]; const float km = k * (1.0f + (a - 1.0f) * kac[e]);
                ssq += kk * kk; bcs += r * km * rkc[e];
                float c = lw; c = dpp_shr_add<1>(c); c = dpp_shr_add<2>(c); c = dpp_shr_add<4>(c); c = dpp_shr_add<8>(c);
                const float E = fexp_(c), Ei = fexp_(-c), Ep = fexp_(c - lw);
                rt_[e] = r * E; kt_[e] = km * Ei; ka_[e] = kk * Ep; kb_[e] = kk * a * Ei;
                vo[e] = v; go[e] = ag[e];
                wcv[e] = E; }
            if (l15 == 15) *(f32x4*)(WSP(float, WS_WC) + ((size_t)gw * 8 + hd) * 64 + j * 16 + kq * 4) = (f32x4){wcv[0], wcv[1], wcv[2], wcv[3]};
            { const int s = j >> 1; const unsigned r0 = cvtpk_a(rt_[0], rt_[1]), r1 = cvtpk_a(rt_[2], rt_[3]), a0_ = cvtpk_a(ka_[0], ka_[1]), a1_ = cvtpk_a(ka_[2], ka_[3]), b0_ = cvtpk_a(kb_[0], kb_[1]), b1_ = cvtpk_a(kb_[2], kb_[3]), k0 = cvtpk_a(kt_[0], kt_[1]), k1 = cvtpk_a(kt_[2], kt_[3]), v0 = cvtpk_a(vo[0], vo[1]), v1 = cvtpk_a(vo[2], vo[3]);
              if (j & 1) { rf[s].z = r0; rf[s].w = r1; kf[s].z = k0; kf[s].w = k1; vf[s].z = v0; vf[s].w = v1; kaf[s].z = a0_; kaf[s].w = a1_; kbf[s].z = b0_; kbf[s].w = b1_; }
              else { rf[s].x = r0; rf[s].y = r1; kf[s].x = k0; kf[s].y = k1; vf[s].x = v0; vf[s].y = v1; kaf[s].x = a0_; kaf[s].y = a1_; kbf[s].x = b0_; kbf[s].y = b1_; } }
            __builtin_amdgcn_sched_barrier(0);
            const size_t o = m * 512 + c0;
            rvp[j] = (v2u){pk2(vo[0], vo[1]), pk2(vo[2], vo[3])}; rgp[j] = (v2u){pk2(go[0], go[1]), pk2(go[2], go[3])}; (void)o; }
#pragma unroll
        for (int j = 0; j < 4; ++j) { const size_t o = m * 512 + (hd * 4 + j) * 16 + kq * 4; *(v2u*)(RV + o) = rvp[j]; *(v2u*)(RG + o) = rgp[j]; }
        ssq += __shfl_xor(ssq, 16); ssq += __shfl_xor(ssq, 32); bcs += __shfl_xor(bcs, 16); bcs += __shfl_xor(bcs, 32);
        const float inv = __builtin_amdgcn_rsqf(fmaxf(ssq, 1e-24f));
#ifndef NO_COPS
        rwkv_chunk_ops(F, (size_t)gw * 8 + hd, m, hd, lane, inv, kaf, kbf, rf, kf, vf);
#endif
        if (kq == 0) BC[m * 8 + hd] = bcs;
        if (hd + 1 < 8) RP_WRITE(buf ^ 1);
        asm volatile("s_waitcnt vmcnt(0)" ::: "memory");
        __syncthreads();
    }
#undef RP_ISSUE
#undef RP_WRITE
#undef RP_LOADH
}

enum Phase { PH_CONV = 0, PH_NORM1, PH_GEMM_IN, PH_PREP, PH_GLASCAN, PH_RWSCAN, PH_POST, PH_GEMM_GLAO, PH_GEMM_RWO, PH_GEMM_OUT, PH_NORM2, PH_ROUTE2, PH_GEMM_UP, PH_GEMM_DN, PH_COMBINE, PH_FINAL, PH_COUNT };

__global__ void __launch_bounds__(NWAVES * 64, 2) mk_fwd(Args args) {
    extern __shared__ __attribute__((aligned(16))) unsigned char lds[];
    Frame F;
    F.lds = (LAS unsigned char*)lds;
    F.MISC = (volatile LAS unsigned*)(F.lds + MISC_OFF);
    F.tid = threadIdx.x; F.lane = F.tid & 63; F.wave = __builtin_amdgcn_readfirstlane(F.tid >> 6);
    F.G = gridDim.x; { const int bx = blockIdx.x; F.vcu = (F.G % 8 == 0) ? (bx % 8) * (F.G / 8) + bx / 8 : bx; }
    F.out = args.out; F.ws = args.ws;
    for (int u = F.tid; u < (LDS_BYTES - LDSCTL_OFF) / 4; u += NWAVES * 64) ((LAS unsigned*)(F.lds + LDSCTL_OFF))[u] = 0u;
    __syncthreads();
    const int fused = args.fused; const bool dry = args.pad != 0;
    float* xdry = (float*)(F.ws + 772 * MiB); bf16* hdry = (bf16*)(F.ws + 900 * MiB);
    XcdBarrier bar; bar.bar = (unsigned*)(F.ws + WS_CTL) + CW_BAR; bar.x = 0; bar.st = nullptr;
    if (fused) bar = xcd_barrier_post((unsigned*)(F.ws + WS_CTL) + CW_BAR, F.MISC + 8);
    const int lo = args.ph_lo, hi = args.ph_hi;
#ifndef NO_D1
#define NO_D1 0
#endif
#ifndef NO_R1
#define NO_R1 0
#endif
#ifndef PHMASK
#define PHMASK 0xFFFFF
#endif
#define IN(k) (((PHMASK >> (k)) & 1) && lo <= (k) && (k) < hi)
#define PB() do { int t_ = threadIdx.x; asm volatile("" : "+v"(t_)); F.tid = t_; F.lane = t_ & 63; F.wave = __builtin_amdgcn_readfirstlane(t_ >> 6); } while (0)
#define SEAM() do { if (fused) xcd_barrier(bar); } while (0)
    PG8_LAS unsigned char* ring = (PG8_LAS unsigned char*)(F.lds + RING_OFF);

    for (int l = args.l_lo; l < args.l_hi; ++l) {
        const bool moe = (l & 1);
        const float* xin = (l == 0) ? args.in[0] : (const float*)F.out;

        if (IN(PH_CONV)) { PB(); if (l == 0) phase_mod(F, args); phase_conv(F, args, l); if (l == 0 || !fused) SEAM(); else __syncthreads(); }

        if (IN(PH_NORM1) && !(l > 0 && ((l - 1) & 1))) { PB(); phase_norm<0>(F, args, l, xin, l > 0); SEAM(); }

        if (IN(PH_GEMM_IN)) { PB();
            pg8::Gemm g{WSP(const bf16, WS_H), WSP(const bf16, WS_WIN), M, NPW, D}; pg8::StaticOrder S; S.init(M, NPW, F.G, (int)blockIdx.x);
            pg8::EpiPlainGate E{WSP(bf16, WS_P), NP, NP / 256, WSP(bf16, WS_GATE), (size_t)M * 1024};
            pg8::gemm_phase<pg8::EpiPlainGate, pg8::StaticOrder, true, true>(ring, g, S, E);
            SEAM();
        }

        if (IN(PH_PREP)) { PB(); if (!fused) phase_gla_d1(F, args, l, F.vcu, 256); if (!NO_R1) phase_rwkv_prep3(F, args, l); SEAM(); }
        if (IN(PH_RWSCAN)) { PB(); if (fused && F.vcu >= 128) phase_gla_d1(F, args, l, F.vcu - 128, 128); else phase_rwkv_seq(F, args); SEAM(); }
        if (IN(PH_GLASCAN)) { PB(); phase_gla_d2(F, args); SEAM(); }

        if (IN(PH_POST)) { PB(); phase_post(F, args, l, dry); SEAM(); }

        if (IN(PH_GEMM_GLAO)) { PB();
            pg8::Gemm g{WSP(const bf16, WS_GO), WSP(const bf16, WS_GLAO), M, D, D}; pg8::StaticOrder S; S.init(M, D, F.G, (int)blockIdx.x);
            pg8::EpiGate E{nullptr, WSP(bf16, WS_H), nullptr, WSP(const bf16, WS_GATE), D};
            pg8::gemm_phase<pg8::EpiGate, pg8::StaticOrder, true, true>(ring, g, S, E);
            VM_WAIT(); __syncthreads();
        }

        if (IN(PH_GEMM_RWO)) { PB();
            pg8::Gemm g{WSP(const bf16, WS_RY), WSP(const bf16, WS_RWO), M, D, 512}; pg8::StaticOrder S; S.init(M, D, F.G, (int)blockIdx.x);
            pg8::EpiGate E{WSP(bf16, WS_MG), nullptr, WSP(const bf16, WS_H), WSP(const bf16, WS_GATE) + (size_t)M * 1024, D};
            pg8::gemm_phase<pg8::EpiGate, pg8::StaticOrder, true, true>(ring, g, S, E);
            SEAM();
        }

        if (IN(PH_GEMM_OUT)) { PB();
            pg8::Gemm g{WSP(const bf16, WS_MG), WSP(const bf16, WS_WOUT), M, D, D}; pg8::StaticOrder S; S.init(M, D, F.G, (int)blockIdx.x);
            pg8::EpiDelta E{WSP(bf16, WS_H), args.in[3] + (size_t)l * 6144 + 2048, WSP(const float, WS_MODP) + (size_t)l * 16 * 6144 + 2048, (size_t)4 * 16 * 6144};
            pg8::gemm_phase<pg8::EpiDelta, pg8::StaticOrder, true, true>(ring, g, S, E);
            SEAM();
        }

        if (IN(PH_NORM2)) { PB(); if (moe) phase_norm<2>(F, args, l, xin, true); else phase_norm<1>(F, args, l, xin, true); SEAM(); }

        if (moe) {
            if (IN(PH_ROUTE2)) { PB(); phase_route2(F, args); SEAM(); }
            if (IN(PH_GEMM_UP)) { PB();
                const int nT = __builtin_amdgcn_readfirstlane(((const int*)(F.ws + WS_MOE + MO_NT))[0]);
                pg8::Gemm g{WSP(const bf16, WS_HA), WSP(const bf16, WS_MUP), nT * 256, 2 * MFF, D}; pg8::MoeOrder S; S.init_moe(nT, 2 * MFF / 256, F.G, (int)blockIdx.x, (const int*)(F.ws + WS_MOE + MO_TILE));
                pg8::EpiSwiglu E{WSP(bf16, WS_U), MFF, 2 * MFF / 256};
                pg8::gemm_phase<pg8::EpiSwiglu, pg8::MoeOrder, true, true>(ring, g, S, E);
                SEAM();
            }
            if (IN(PH_GEMM_DN)) { PB();
                const int nT = __builtin_amdgcn_readfirstlane(((const int*)(F.ws + WS_MOE + MO_NT))[0]);
                pg8::Gemm g{WSP(const bf16, WS_U), WSP(const bf16, WS_MDN), nT * 256, D, MFF}; pg8::MoeOrder S; S.init_moe(nT, D / 256, F.G, (int)blockIdx.x, (const int*)(F.ws + WS_MOE + MO_TILE));
                pg8::EpiPlain E{WSP(bf16, WS_HA), D, D / 256};
                pg8::gemm_phase<pg8::EpiPlain, pg8::MoeOrder, true, true>(ring, g, S, E);
                SEAM();
            }
            if (IN(PH_COMBINE)) { PB(); phase_combine(F, args, l, dry); SEAM(); }
        } else {
            if (IN(PH_GEMM_UP)) { PB();
                pg8::Gemm g{WSP(const bf16, WS_H), WSP(const bf16, WS_FUP), M, 2 * FFN, D}; pg8::StaticOrder S; S.init(M, 2 * FFN, F.G, (int)blockIdx.x);
                pg8::EpiSwiglu E{WSP(bf16, WS_U), FFN, 1 << 20};
                pg8::gemm_phase<pg8::EpiSwiglu, pg8::StaticOrder, true, true>(ring, g, S, E);
                SEAM();
            }
            if (IN(PH_GEMM_DN)) { PB();
                pg8::Gemm g{WSP(const bf16, WS_U), WSP(const bf16, WS_FDN), M, D, FFN}; pg8::StaticOrder S; S.init(M, D, F.G, (int)blockIdx.x);
                pg8::EpiDelta E{WSP(bf16, WS_H), args.in[3] + (size_t)l * 6144 + 5120, WSP(const float, WS_MODP) + (size_t)l * 16 * 6144 + 5120, (size_t)4 * 16 * 6144};
                pg8::gemm_phase<pg8::EpiDelta, pg8::StaticOrder, true, true>(ring, g, S, E);
                SEAM();
            }
        }
        if (l == DEPTH - 1 && !moe && IN(PH_FINAL)) { PB(); phase_final(F, args); }
    }
#undef IN
#undef SEAM
}

extern "C" void kernel_launch(void* const* d_in, const int* in_sizes, int n_in, void* d_out, int out_size, void* d_ws, size_t ws_size, hipStream_t stream) {
    static int grid = 0;
    if (grid == 0) {
        if (n_in != 32 || in_sizes[0] != M * D || out_size != M * D || ws_size < WS_END) { fprintf(stderr, "kernel_launch: unexpected shapes / workspace (n_in %d, ws %zu, need %zu); nothing launched\n", n_in, ws_size, (size_t)WS_END); grid = -1; return; }
        int dev = 0, cus = 0, per_cu = 0;
        if (hipGetDevice(&dev) != hipSuccess || hipDeviceGetAttribute(&cus, hipDeviceAttributeMultiprocessorCount, dev) != hipSuccess) { grid = -1; return; }
        if (hipFuncSetAttribute((const void*)mk_fwd, hipFuncAttributeMaxDynamicSharedMemorySize, LDS_BYTES) != hipSuccess) { fprintf(stderr, "kernel_launch: hipFuncSetAttribute failed\n"); grid = -1; return; }
        if (hipOccupancyMaxActiveBlocksPerMultiprocessor(&per_cu, (const void*)mk_fwd, NWAVES * 64, LDS_BYTES) != hipSuccess || per_cu < 1) fprintf(stderr, "kernel_launch: occupancy query reports %d\n", per_cu);
        (void)hipGetLastError();
        grid = 256;
        if (cus < 256) { fprintf(stderr, "kernel_launch: %d CUs < 256; nothing launched\n", cus); grid = -1; return; }
    }
    if (grid < 0) return;
    if (hipMemsetAsync((char*)d_ws + WS_CTL, 0, CTL_ZERO_BYTES, stream) != hipSuccess) return;
    Args a{};
    for (int i = 0; i < 32; ++i) a.in[i] = (const float*)d_in[i];
    a.out = (float*)d_out; a.ws = (unsigned char*)d_ws;
#if MK_FUSED
    a.l_lo = 0; a.l_hi = DEPTH; a.ph_lo = 0; a.ph_hi = PH_COUNT; a.fused = 1;
    hipLaunchKernelGGL(mk_fwd, dim3(grid), dim3(NWAVES * 64), LDS_BYTES, stream, a);
#else
    for (int l = 0; l < DEPTH; ++l)
        for (int pi = 0; pi < PH_COUNT; ++pi) {
            const int ph = (pi == PH_GLASCAN) ? PH_RWSCAN : (pi == PH_RWSCAN) ? PH_GLASCAN : pi;
            if (!(l & 1) && (ph == PH_ROUTE2 || ph == PH_COMBINE)) continue;
            if (ph == PH_FINAL) continue;
            if (ph == PH_NORM1 && l > 0 && ((l - 1) & 1)) continue;
            a.l_lo = l; a.l_hi = l + 1; a.ph_lo = ph; a.ph_hi = ph + 1; a.fused = 0;
#ifndef REPMASK
#define REPMASK 0
#endif
            const bool inplace = (ph == PH_POST || ph == PH_COMBINE);
            const bool norep = (ph == PH_FINAL || ph == PH_NORM1 || ph == PH_NORM2 || (ph == PH_RWSCAN));
            const int nrep = (((REPMASK >> ph) & 1) && !norep) ? 2 : 1;
            for (int rep = 0; rep < nrep; ++rep) { a.pad = (inplace && nrep == 2 && rep == 0) ? 1 : 0;
            hipLaunchKernelGGL(mk_fwd, dim3(grid), dim3(NWAVES * 64), LDS_BYTES, stream, a); }
        }
#endif
}
```
